# Optimizing an MI355X kernel written in HIP

```python
import math
import jax, jax.numpy as jnp
from jax import lax
import numpy as np

D_MODEL = 1024
BATCH = 4
SEQ = 4096
DEPTH = 4

N_MIXERS = 2
N_GLA = (DEPTH + 1) // 2
N_POOL = DEPTH // 2

GLA_HEADS = 4
GLA_KD = D_MODEL // 2
GLA_VD = D_MODEL
GLA_DK = GLA_KD // GLA_HEADS
GLA_DV = GLA_VD // GLA_HEADS
GLA_GATE_RANK = 16
GLA_GATE_NORMALIZER = 16.0
GLA_CHUNK = 64
GLA_IN = 2 * GLA_KD + 2 * GLA_VD + GLA_GATE_RANK

POOL_EXPAND = 2
POOL_WIDTH = POOL_EXPAND * D_MODEL
POOL_WINDOWS = (2, 4, 8, 16)
POOL_GROUPS = len(POOL_WINDOWS)
POOL_GW = POOL_WIDTH // POOL_GROUPS

DEEPNORM_ALPHA = (2.0 * DEPTH) ** 0.25
DEEPNORM_BETA = (8.0 * DEPTH) ** -0.25
LN_EPS = 1e-5
RMS_EPS = 1e-6

kernel_name = "gla_pool_interleaved_deepnorm"


def _layernorm(x, g, b):
    xf = x.astype(jnp.float32)
    mu = jnp.mean(xf, axis=-1, keepdims=True)
    var = jnp.mean(jnp.square(xf - mu), axis=-1, keepdims=True)
    y = (xf - mu) * lax.rsqrt(var + LN_EPS) * g.astype(jnp.float32) + b.astype(jnp.float32)
    return y.astype(x.dtype)


def _gla_mixer(x, w_in, w_gk, b_gk, norm_w, w_out):
    B, T, _ = x.shape
    nc = T // GLA_CHUNK
    h = (x @ w_in).astype(jnp.float32)
    q, k, v, g, lr = jnp.split(
        h, [GLA_KD, 2 * GLA_KD, 2 * GLA_KD + GLA_VD, 2 * GLA_KD + 2 * GLA_VD], axis=-1)
    gk = jax.nn.log_sigmoid(lr @ w_gk.astype(jnp.float32) + b_gk.astype(jnp.float32))
    gk = gk / GLA_GATE_NORMALIZER

    def heads(t, dh):
        return t.reshape(B, nc, GLA_CHUNK, GLA_HEADS, dh).transpose(0, 3, 1, 2, 4)

    q = heads(q, GLA_DK) * (GLA_DK ** -0.5)
    k = heads(k, GLA_DK)
    v = heads(v, GLA_DV)
    gk = heads(gk, GLA_DK)

    bcum = jnp.cumsum(gk, axis=-2)
    b_last = bcum[..., -1:, :]
    qe = q * jnp.exp(bcum)
    ke = k * jnp.exp(-bcum)
    kd = k * jnp.exp(b_last - bcum)

    mask = jnp.tril(jnp.ones((GLA_CHUNK, GLA_CHUNK), dtype=bool))
    scores = jnp.einsum('bhncd,bhnsd->bhncs', qe, ke)
    scores = jnp.where(mask, scores, 0.0)
    o_intra = jnp.einsum('bhncs,bhnsv->bhncv', scores, v)

    kv = jnp.einsum('bhncd,bhncv->bhndv', kd, v)
    decay = jnp.exp(b_last[..., 0, :])

    def step(S, inp):
        dec, kvc = inp
        return dec[..., None] * S + kvc, S

    S0 = jnp.zeros((B, GLA_HEADS, GLA_DK, GLA_DV), jnp.float32)
    _, S_prev = lax.scan(step, S0, (jnp.moveaxis(decay, 2, 0), jnp.moveaxis(kv, 2, 0)))
    S_prev = jnp.moveaxis(S_prev, 0, 2)
    o = o_intra + jnp.einsum('bhncd,bhndv->bhncv', qe, S_prev)

    o = o.transpose(0, 2, 3, 1, 4).reshape(B, T, GLA_HEADS, GLA_DV)
    o = o * lax.rsqrt(jnp.mean(jnp.square(o), axis=-1, keepdims=True) + RMS_EPS)
    o = o * norm_w.astype(jnp.float32)
    o = o.reshape(B, T, GLA_VD) * jax.nn.silu(g)
    return o.astype(x.dtype) @ w_out


def _pool_mixer(x, w_in, w_grp, b_grp, scale, w_out):
    B, T, _ = x.shape
    h = x @ w_in
    u, z = jnp.split(h, [POOL_WIDTH], axis=-1)
    u = u.astype(jnp.float32).reshape(B, T, POOL_GROUPS, POOL_GW)
    cs = jnp.cumsum(u, axis=1)
    pos = jnp.arange(1, T + 1, dtype=jnp.float32)
    pooled = []
    for gi, w in enumerate(POOL_WINDOWS):
        cs_g = cs[:, :, gi]
        lag = jnp.pad(cs_g, ((0, 0), (w, 0), (0, 0)))[:, :T]
        cnt = jnp.minimum(pos, float(w))[None, :, None]
        pooled.append((cs_g - lag) / cnt)
    p = jnp.stack(pooled, axis=2) - u
    m = jnp.einsum('btgc,gcd->btgd', p, w_grp.astype(jnp.float32)) + b_grp.astype(jnp.float32)
    m = m.reshape(B, T, POOL_WIDTH) * scale.astype(jnp.float32)
    y = m * jax.nn.silu(z.astype(jnp.float32))
    return y.astype(x.dtype) @ w_out


def setup_inputs(seed: int = 0) -> dict:
    key = jax.random.key(seed)
    ks = jax.random.split(key, 16)
    f32 = jnp.float32
    nrm = lambda k, s, sc: (jax.random.normal(k, s, f32) * sc)
    return {
        "x": jax.random.normal(ks[0], (BATCH, SEQ, D_MODEL), f32),
        "gla_w_in": nrm(ks[1], (N_GLA, D_MODEL, GLA_IN), D_MODEL ** -0.5),
        "gla_w_gk": nrm(ks[2], (N_GLA, GLA_GATE_RANK, GLA_KD), GLA_GATE_RANK ** -0.5),
        "gla_b_gk": nrm(ks[3], (N_GLA, GLA_KD), 0.02),
        "gla_norm_w": 1.0 + nrm(ks[4], (N_GLA, GLA_DV), 0.02),
        "gla_w_out": nrm(ks[5], (N_GLA, GLA_VD, D_MODEL), GLA_VD ** -0.5 * DEEPNORM_BETA),
        "pool_w_in": nrm(ks[6], (N_POOL, D_MODEL, 2 * POOL_WIDTH), D_MODEL ** -0.5),
        "pool_w_grp": nrm(ks[7], (N_POOL, POOL_GROUPS, POOL_GW, POOL_GW), POOL_GW ** -0.5),
        "pool_b_grp": nrm(ks[8], (N_POOL, POOL_GROUPS, POOL_GW), 0.02),
        "pool_scale": 1.0 + nrm(ks[9], (N_POOL, POOL_WIDTH), 0.02),
        "pool_w_out": nrm(ks[10], (N_POOL, POOL_WIDTH, D_MODEL), POOL_WIDTH ** -0.5 * DEEPNORM_BETA),
        "ln_g": 1.0 + nrm(ks[11], (DEPTH, D_MODEL), 0.02),
        "ln_b": nrm(ks[12], (DEPTH, D_MODEL), 0.02),
    }


def reference(x, gla_w_in, gla_w_gk, gla_b_gk, gla_norm_w, gla_w_out,
              pool_w_in, pool_w_grp, pool_b_grp, pool_scale, pool_w_out, ln_g, ln_b):
    for i in range(DEPTH):
        j = i // N_MIXERS
        if i % N_MIXERS == 0:
            y = _gla_mixer(x, gla_w_in[j], gla_w_gk[j], gla_b_gk[j], gla_norm_w[j], gla_w_out[j])
        else:
            y = _pool_mixer(x, pool_w_in[j], pool_w_grp[j], pool_b_grp[j], pool_scale[j], pool_w_out[j])
        x = _layernorm(DEEPNORM_ALPHA * x + y, ln_g[i], ln_b[i])
    return x
```

```cpp
#include <hip/hip_runtime.h>
#include <hip/hip_cooperative_groups.h>
#include <cstdio>
namespace cg = cooperative_groups;

#define LAS __attribute__((address_space(3)))
typedef unsigned short bf16_t;
typedef short bf16x8 __attribute__((ext_vector_type(8)));
typedef float f32x4 __attribute__((ext_vector_type(4)));
typedef unsigned u32x4 __attribute__((ext_vector_type(4)));
typedef unsigned u32x2 __attribute__((ext_vector_type(2)));

constexpr int M = 16384, D = 1024, T = 4096;
constexpr int GH = 4, DK = 128, DV = 256, GR = 16, GNIN = 3088, GNH = 3072;
constexpr int GC = 4, NG = 16;
constexpr int PW = 2048;
constexpr float ALPHA = 1.6817928305074292f;
constexpr float LN_EPS = 1e-5f, RMS_EPS = 1e-6f;
constexpr int NTHREADS = 512;
constexpr int LDS_BYTES = 147456;

constexpr size_t MiB = 1u << 20;
constexpr size_t WS_W = 1 * MiB;
constexpr size_t W_GIN = 0, W_GIN_SZ = (size_t)GNH * D * 2;
constexpr size_t W_GOUT = 2 * W_GIN_SZ, W_GOUT_SZ = (size_t)D * D * 2;
constexpr size_t W_PIN = W_GOUT + 2 * W_GOUT_SZ, W_PIN_SZ = (size_t)4096 * D * 2;
constexpr size_t W_PGRP = W_PIN + 2 * W_PIN_SZ, W_PGRP_SZ = (size_t)2048 * 512 * 2;
constexpr size_t W_POUT = W_PGRP + 2 * W_PGRP_SZ, W_POUT_SZ = (size_t)D * 2048 * 2;
constexpr size_t W_LR = W_POUT + 2 * W_POUT_SZ, W_LR_SZ = (size_t)16 * D * 2;
constexpr size_t W_END = W_LR + 2 * W_LR_SZ;
static_assert(WS_W + W_END <= 48 * MiB, "weights");
constexpr size_t WS_XB = 48 * MiB;
constexpr size_t WS_OG = 48 * MiB;
constexpr size_t WS_P = 48 * MiB;
constexpr size_t WS_LR = 80 * MiB;
constexpr size_t WS_DEC = 81 * MiB;
constexpr size_t WS_H = 112 * MiB;
constexpr size_t WS_Z = 176 * MiB;
constexpr size_t WS_KVG = 208 * MiB;
constexpr size_t WS_Y = 112 * MiB;

__device__ __forceinline__ unsigned cvt_pk_bf16(float lo, float hi) { unsigned r; asm volatile("v_cvt_pk_bf16_f32 %0, %1, %2" : "=v"(r) : "v"(lo), "v"(hi)); return r; }
__device__ __forceinline__ bf16_t f2bf(float f) { return (bf16_t)(cvt_pk_bf16(f, 0.f) & 0xffffu); }
__device__ __forceinline__ float bf2f(bf16_t b) { return __uint_as_float(((unsigned)b) << 16); }
__device__ __forceinline__ float bflo(unsigned w) { return __uint_as_float(w << 16); }
__device__ __forceinline__ float bfhi(unsigned w) { return __uint_as_float(w & 0xffff0000u); }
__device__ __forceinline__ float silu_f(float z) { return z / (1.f + __expf(-z)); }
__device__ __forceinline__ float wave_sum(float v) {
#pragma unroll
    for (int o = 1; o < 64; o <<= 1) v += __shfl_xor(v, o);
    return v;
}

namespace pg8 {
constexpr int BM = 256, BK = 64, HALF = 128, HTB = HALF * BK * 2, STAGE_BYTES = 8 * HTB, NXCD = 8, WGM = 8;
__host__ __device__ __forceinline__ int lds_byte(int r, int c) { const int st = (r >> 4) * 2 + (c >> 5), rr = r & 15, cc = c & 31, ob = rr * 64 + cc * 2; return st * 1024 + (ob ^ (((ob >> 9) & 1) << 5)); }
__host__ __device__ __forceinline__ void stage_rc(int b, int& R, int& C) { const int st = b / 1024, sb = b % 1024, swz = sb ^ (((sb >> 9) & 1) << 5); R = (st >> 1) * 16 + swz / 64; C = (st & 1) * 32 + (swz % 64) / 2; }
__host__ __device__ __forceinline__ int perm32(int rho) { const int n = rho >> 4, i = rho & 15; return 8 * (i >> 2) + 4 * n + (i & 3); }

struct Unit { int pm, pn; };
struct Gemm { const bf16_t* A; const bf16_t* Bt; int M, N, K, lda, grp_div, grp_off; };

struct StaticOrder {
    int nM, nN, nwg, G, c;
    __device__ void init(int M_, int N_, int G_, int c_) { nM = M_ / BM; nN = N_ / BM; nwg = nM * nN; G = G_; c = c_; }
    __device__ bool next(int i, Unit& u) const {
        const long L = (long)i * G + c; if (L >= nwg) return false;
        int wgid = (int)L; { const int q = nwg / NXCD, r = nwg % NXCD, xcd = wgid % NXCD, off = wgid / NXCD; wgid = (xcd < r ? xcd * (q + 1) : r * (q + 1) + (xcd - r) * q) + off; }
        const int nig = WGM * nN, gid = wgid / nig, fm = gid * WGM, gsz = (nM - fm) < WGM ? (nM - fm) : WGM;
        u.pm = fm + ((wgid % nig) % gsz); u.pn = (wgid % nig) / gsz; return true;
    }
};

struct EpiBf16 {
    static constexpr bool PERM = true;
    bf16_t* O; int ldc; int split_cols; size_t split_stride;
    __device__ __forceinline__ void operator()(const f32x4 (&acc)[2][2][4][2], const Unit& u, int wr, int wc, int fr, int fq) const {
        const int row0 = u.pm * BM + wr * 64 + fr; int colt = u.pn * BM; bf16_t* base = O;
        if (split_cols) { const int t = colt / split_cols; base += (size_t)t * split_stride; colt -= t * split_cols; }
        const int col0 = colt + wc * 32 + 8 * fq;
#pragma unroll
        for (int ai = 0; ai < 2; ++ai)
#pragma unroll
            for (int m = 0; m < 4; ++m) { bf16_t* rowp = base + (size_t)(row0 + ai * HALF + m * 16) * ldc + col0;
#pragma unroll
                for (int bj = 0; bj < 2; ++bj) { const f32x4 v0 = acc[ai][bj][m][0], v1 = acc[ai][bj][m][1];
                    u32x4 w; w.x = cvt_pk_bf16(v0[0], v0[1]); w.y = cvt_pk_bf16(v0[2], v0[3]); w.z = cvt_pk_bf16(v1[0], v1[1]); w.w = cvt_pk_bf16(v1[2], v1[3]);
                    *(u32x4*)(rowp + bj * HALF) = w; } }
    }
};
struct EpiRes {
    static constexpr bool PERM = false;
    const float* base; float* out; int ldc;
    __device__ __forceinline__ void operator()(const f32x4 (&acc)[2][2][4][2], const Unit& u, int wr, int wc, int fr, int fq) const {
        const int row0 = u.pm * BM + wr * 64 + fr, col0 = u.pn * BM + wc * 32 + 4 * fq;
#pragma unroll
        for (int ai = 0; ai < 2; ++ai)
#pragma unroll
            for (int m = 0; m < 4; ++m) { const size_t off = (size_t)(row0 + ai * HALF + m * 16) * ldc + col0;
#pragma unroll
                for (int bj = 0; bj < 2; ++bj)
#pragma unroll
                    for (int n = 0; n < 2; ++n) { const f32x4 bs = *(const f32x4*)(base + off + bj * HALF + n * 16);
                        *(f32x4*)(out + off + bj * HALF + n * 16) = bs * ALPHA + acc[ai][bj][m][n]; } }
    }
};
struct EpiPool {
    static constexpr bool PERM = true;
    bf16_t* Y; const bf16_t* Z; const float* bias; const float* scale;
    __device__ __forceinline__ void operator()(const f32x4 (&acc)[2][2][4][2], const Unit& u, int wr, int wc, int fr, int fq) const {
        const int row0 = u.pm * BM + wr * 64 + fr, col0 = u.pn * BM + wc * 32 + 8 * fq;
        f32x4 bv[2][2], sv[2][2];
#pragma unroll
        for (int bj = 0; bj < 2; ++bj)
#pragma unroll
            for (int n = 0; n < 2; ++n) { bv[bj][n] = *(const f32x4*)(bias + col0 + bj * HALF + 4 * n); sv[bj][n] = *(const f32x4*)(scale + col0 + bj * HALF + 4 * n); }
#pragma unroll
        for (int ai = 0; ai < 2; ++ai)
#pragma unroll
            for (int m = 0; m < 4; ++m) { const size_t off = (size_t)(row0 + ai * HALF + m * 16) * PW + col0;
#pragma unroll
                for (int bj = 0; bj < 2; ++bj) {
                    const u32x4 zz = *(const u32x4*)(Z + off + bj * HALF);
                    f32x4 v0 = (acc[ai][bj][m][0] + bv[bj][0]) * sv[bj][0], v1 = (acc[ai][bj][m][1] + bv[bj][1]) * sv[bj][1];
                    v0[0] *= silu_f(bflo(zz.x)); v0[1] *= silu_f(bfhi(zz.x)); v0[2] *= silu_f(bflo(zz.y)); v0[3] *= silu_f(bfhi(zz.y));
                    v1[0] *= silu_f(bflo(zz.z)); v1[1] *= silu_f(bfhi(zz.z)); v1[2] *= silu_f(bflo(zz.w)); v1[3] *= silu_f(bfhi(zz.w));
                    u32x4 w; w.x = cvt_pk_bf16(v0[0], v0[1]); w.y = cvt_pk_bf16(v0[2], v0[3]); w.z = cvt_pk_bf16(v1[0], v1[1]); w.w = cvt_pk_bf16(v1[2], v1[3]);
                    *(u32x4*)(Y + off + bj * HALF) = w; } }
    }
};

template <class Epi, class Sched>
__device__ __forceinline__ void gemm_phase(LAS unsigned char* lds, const Gemm g, const Sched& S, const Epi& E) {
    int tid = threadIdx.x; asm volatile("" : "+v"(tid));
    const int wid = __builtin_amdgcn_readfirstlane(tid >> 6), lane = tid & 63, wr = wid >> 2, wc = wid & 3, fr = lane & 15, fq = lane >> 4;
    const int K = g.K, nt = K / BK, lda = g.lda;
    unsigned voffA[2], voffB[2];
#pragma unroll
    for (int i = 0; i < 2; ++i) { int R, C; stage_rc(tid * 16 + i * 8192, R, C); const int Rb = Epi::PERM ? ((R & ~31) + perm32(R & 31)) : R;
        voffA[i] = (unsigned)(R * lda + C) * 2u; voffB[i] = (unsigned)(Rb * K + C) * 2u; }
    const size_t kstep = (size_t)(BK * 2);
    const size_t hstepA = (size_t)HALF * lda * 2, hstepB = (size_t)HALF * K * 2;
    const size_t tstepA = 2 * hstepA, tstepB = 2 * hstepB;
    const unsigned ldsw = (unsigned)wid * 1024u;
    const int aoff = lds_byte(wr * 64 + fr, fq * 8), boff = lds_byte(wc * 32 + fr, fq * 8);
#define PG8_SA(b, h) (((b) * 2 + (h)) * HTB)
#define PG8_SB(b, h) ((4 + (b) * 2 + (h)) * HTB)
#define PG8_STAGE(bufoff, gbase, voff) do { _Pragma("unroll") for (int _i = 0; _i < 2; ++_i) \
        __builtin_amdgcn_global_load_lds((const unsigned*)((const char*)(gbase) + (voff)[_i]), (LAS unsigned*)(lds + (bufoff) + ldsw + _i * 8192), 16, 0, 0); } while (0)
#define PG8_LDA(dst, b, h) do { _Pragma("unroll") for (int m = 0; m < 4; ++m) _Pragma("unroll") for (int k = 0; k < 2; ++k) dst[m][k] = *(const LAS bf16x8*)(lds + PG8_SA(b, h) + aoff + m * 2048 + k * 1024); } while (0)
#define PG8_LDB(dst, b, h) do { _Pragma("unroll") for (int n = 0; n < 2; ++n) _Pragma("unroll") for (int k = 0; k < 2; ++k) dst[n][k] = *(const LAS bf16x8*)(lds + PG8_SB(b, h) + boff + n * 2048 + k * 1024); } while (0)
#define PG8_MMA(ai, bj, At, Bt) do { __builtin_amdgcn_s_setprio(1); _Pragma("unroll") for (int m = 0; m < 4; ++m) _Pragma("unroll") for (int n = 0; n < 2; ++n) _Pragma("unroll") for (int k = 0; k < 2; ++k) \
        acc[ai][bj][m][n] = __builtin_amdgcn_mfma_f32_16x16x32_bf16(Bt[n][k], At[m][k], acc[ai][bj][m][n], 0, 0, 0); __builtin_amdgcn_s_setprio(0); } while (0)
#define PG8_WAIT_V(n) asm volatile("s_waitcnt vmcnt(" #n ")" ::: "memory")
#define PG8_WAIT_L(n) asm volatile("s_waitcnt lgkmcnt(" #n ")" ::: "memory")
#define PG8_BAR __builtin_amdgcn_s_barrier()
#define PG8_SCHED __builtin_amdgcn_sched_barrier(0)
    Unit cur, nxt; int ui = 0;
    if (!S.next(0, cur)) return;
    f32x4 acc[2][2][4][2];
#pragma unroll
    for (int a = 0; a < 2; ++a)
#pragma unroll
        for (int b = 0; b < 2; ++b)
#pragma unroll
            for (int m = 0; m < 4; ++m)
#pragma unroll
                for (int n = 0; n < 2; ++n) acc[a][b][m][n] = (f32x4){0.f, 0.f, 0.f, 0.f};
    bf16x8 At[4][2], B0[2][2], B1[2][2];
    const char* cA = (const char*)g.A + (size_t)cur.pm * tstepA + (size_t)(cur.pn / g.grp_div) * g.grp_off * 2; const char* cB = (const char*)g.Bt + (size_t)cur.pn * tstepB;
    PG8_STAGE(PG8_SB(0, 0), cB, voffB); PG8_STAGE(PG8_SA(0, 0), cA, voffA); PG8_STAGE(PG8_SB(0, 1), cB + hstepB, voffB); PG8_STAGE(PG8_SA(0, 1), cA + hstepA, voffA);
    if (wr == 1) PG8_BAR;
    PG8_WAIT_V(4); PG8_BAR;
    PG8_STAGE(PG8_SB(1, 0), cB + kstep, voffB); PG8_STAGE(PG8_SA(1, 0), cA + kstep, voffA); PG8_STAGE(PG8_SB(1, 1), cB + hstepB + kstep, voffB);
    PG8_WAIT_V(6); PG8_BAR;
    for (;;) {
        const bool has_next = S.next(ui + 1, nxt);
        const char* nA = has_next ? (const char*)g.A + (size_t)nxt.pm * tstepA + (size_t)(nxt.pn / g.grp_div) * g.grp_off * 2 : cA; const char* nB = has_next ? (const char*)g.Bt + (size_t)nxt.pn * tstepB : cB;
        for (int t = 0; t < nt; t += 2) {
            const bool last = (t == nt - 2);
            const char* a1 = cA + (size_t)(t + 1) * kstep;
            const char* a2 = last ? nA : cA + (size_t)(t + 2) * kstep; const char* b2 = last ? nB : cB + (size_t)(t + 2) * kstep;
            const char* a3 = a2 + kstep; const char* b3 = b2 + kstep;
            PG8_LDB(B0, 0, 0); PG8_SCHED; PG8_LDA(At, 0, 0); PG8_STAGE(PG8_SA(1, 1), a1 + hstepA, voffA);
            PG8_WAIT_L(8); PG8_BAR; PG8_WAIT_L(0); PG8_MMA(0, 0, At, B0); PG8_BAR; PG8_SCHED;
            PG8_LDB(B1, 0, 1); PG8_STAGE(PG8_SB(0, 0), b2, voffB);
            PG8_BAR; PG8_WAIT_L(0); PG8_MMA(0, 1, At, B1); PG8_BAR;
            PG8_LDA(At, 0, 1); PG8_STAGE(PG8_SA(0, 0), a2, voffA);
            PG8_BAR; PG8_WAIT_L(0); PG8_MMA(1, 0, At, B0); PG8_BAR; PG8_SCHED;
            PG8_STAGE(PG8_SB(0, 1), b2 + hstepB, voffB);
            PG8_WAIT_V(6); PG8_BAR; PG8_MMA(1, 1, At, B1); PG8_BAR;
            PG8_LDB(B0, 1, 0); PG8_SCHED; PG8_LDA(At, 1, 0); PG8_STAGE(PG8_SA(0, 1), a2 + hstepA, voffA);
            PG8_WAIT_L(8); PG8_BAR; PG8_WAIT_L(0); PG8_MMA(0, 0, At, B0); PG8_BAR; PG8_SCHED;
            PG8_LDB(B1, 1, 1); PG8_STAGE(PG8_SB(1, 0), b3, voffB);
            PG8_BAR; PG8_WAIT_L(0); PG8_MMA(0, 1, At, B1); PG8_BAR;
            PG8_LDA(At, 1, 1); PG8_STAGE(PG8_SA(1, 0), a3, voffA);
            PG8_BAR; PG8_WAIT_L(0); PG8_MMA(1, 0, At, B0); PG8_BAR; PG8_SCHED;
            PG8_STAGE(PG8_SB(1, 1), b3 + hstepB, voffB);
            PG8_WAIT_V(6); PG8_BAR; PG8_MMA(1, 1, At, B1); PG8_BAR;
        }
        E(acc, cur, wr, wc, fr, fq);
        if (!has_next) break;
#pragma unroll
        for (int a = 0; a < 2; ++a)
#pragma unroll
            for (int b = 0; b < 2; ++b)
#pragma unroll
                for (int m = 0; m < 4; ++m)
#pragma unroll
                    for (int n = 0; n < 2; ++n) acc[a][b][m][n] = (f32x4){0.f, 0.f, 0.f, 0.f};
        cur = nxt; cA = nA; cB = nB; ++ui;
    }
    PG8_WAIT_V(0);
    if (wr == 0) PG8_BAR;
    PG8_BAR;
#undef PG8_SA
#undef PG8_SB
#undef PG8_STAGE
#undef PG8_LDA
#undef PG8_LDB
#undef PG8_MMA
#undef PG8_WAIT_V
#undef PG8_WAIT_L
#undef PG8_BAR
#undef PG8_SCHED
}
}

struct Args { const float* in[13]; float* out; unsigned char* ws; };
enum { I_X = 0, I_GWIN, I_GWGK, I_GBGK, I_GNW, I_GWOUT, I_PWIN, I_PWGRP, I_PBGRP, I_PSCALE, I_PWOUT, I_LNG, I_LNB };

__device__ __forceinline__ void transpose_item(const float* W, int ldw, int K, int N, bf16_t* WT, int row_off, float* scr, int item, int lane) {
    const int nblk = N / 32, kb = item / nblk, nb = item % nblk, k0 = 64 * kb, n0 = 32 * nb;
#pragma unroll 8
    for (int i = 0; i < 32; ++i) { const int kk = 2 * i + (lane >> 5); scr[kk * 33 + (lane & 31)] = W[(size_t)(k0 + kk) * ldw + n0 + (lane & 31)]; }
    asm volatile("s_waitcnt lgkmcnt(0)" ::: "memory");
    const int c = lane & 7;
#pragma unroll
    for (int j = 0; j < 4; ++j) { const int n = (lane >> 3) + 8 * j; const float* s = scr + (8 * c) * 33 + n;
        u32x4 o; o.x = cvt_pk_bf16(s[0 * 33], s[1 * 33]); o.y = cvt_pk_bf16(s[2 * 33], s[3 * 33]); o.z = cvt_pk_bf16(s[4 * 33], s[5 * 33]); o.w = cvt_pk_bf16(s[6 * 33], s[7 * 33]);
        *(u32x4*)(WT + (size_t)(row_off + n0 + n) * K + k0 + 8 * c) = o; }
    asm volatile("s_waitcnt lgkmcnt(0)" ::: "memory");
}

__device__ __forceinline__ void prologue_phase(const Args& a, unsigned char* smem, int wid, int lane) {
    unsigned char* wsw = a.ws + WS_W;
    float* scr = (float*)(smem + wid * 16384);
    const int gw = blockIdx.x * 8 + wid, NGW = gridDim.x * 8;
    constexpr int I_A = 16 * 96, I_B = 16 * 32, I_C = 16 * 128, I_D = 8 * 16, I_E = 32 * 32;
    constexpr int PER_J = I_A + I_B + I_C + 4 * I_D + I_E;
    for (int it = gw; it < 2 * PER_J; it += NGW) {
        const int j = it / PER_J; int r = it % PER_J;
        if (r < I_A) { transpose_item(a.in[I_GWIN] + (size_t)j * D * GNIN, GNIN, D, GNH, (bf16_t*)(wsw + W_GIN + j * W_GIN_SZ), 0, scr, r, lane); continue; } r -= I_A;
        if (r < I_B) { transpose_item(a.in[I_GWOUT] + (size_t)j * D * D, D, D, D, (bf16_t*)(wsw + W_GOUT + j * W_GOUT_SZ), 0, scr, r, lane); continue; } r -= I_B;
        if (r < I_C) { transpose_item(a.in[I_PWIN] + (size_t)j * D * 4096, 4096, D, 4096, (bf16_t*)(wsw + W_PIN + j * W_PIN_SZ), 0, scr, r, lane); continue; } r -= I_C;
        if (r < 4 * I_D) { const int g = r / I_D; transpose_item(a.in[I_PWGRP] + (size_t)(j * 4 + g) * 512 * 512, 512, 512, 512, (bf16_t*)(wsw + W_PGRP + j * W_PGRP_SZ), g * 512, scr, r % I_D, lane); continue; } r -= 4 * I_D;
        transpose_item(a.in[I_PWOUT] + (size_t)j * 2048 * D, D, 2048, D, (bf16_t*)(wsw + W_POUT + j * W_POUT_SZ), 0, scr, r, lane);
    }
    const int gt = blockIdx.x * NTHREADS + threadIdx.x, NGT = gridDim.x * NTHREADS;
    for (int idx = gt; idx < 2 * 16 * D; idx += NGT) { const int j = idx >> 14, n = (idx >> 10) & 15, k = idx & 1023;
        ((bf16_t*)(wsw + W_LR + j * W_LR_SZ))[n * D + k] = f2bf(a.in[I_GWIN][(size_t)j * D * GNIN + (size_t)k * GNIN + GNH + n]); }
    const float* x = a.in[I_X]; bf16_t* xb = (bf16_t*)(a.ws + WS_XB);
    for (size_t i = (size_t)gt * 8; i < (size_t)M * D; i += (size_t)NGT * 8) {
        const f32x4 v0 = *(const f32x4*)(x + i), v1 = *(const f32x4*)(x + i + 4);
        u32x4 w; w.x = cvt_pk_bf16(v0[0], v0[1]); w.y = cvt_pk_bf16(v0[2], v0[3]); w.z = cvt_pk_bf16(v1[0], v1[1]); w.w = cvt_pk_bf16(v1[2], v1[3]);
        *(u32x4*)(xb + i) = w; }
}

__device__ __forceinline__ void lr_phase(const bf16_t* xb, const bf16_t* wlr, float* LR, int wid, int lane) {
    const int gw = blockIdx.x * 8 + wid, NGW = gridDim.x * 8, fr = lane & 15, fq = lane >> 4;
    for (int rg = gw; rg < M / 16; rg += NGW) {
        f32x4 acc = (f32x4){0.f, 0.f, 0.f, 0.f};
        const bf16_t* ap = xb + (size_t)(rg * 16 + fr) * D + 8 * fq; const bf16_t* bp = wlr + (size_t)fr * D + 8 * fq;
#pragma unroll 8
        for (int ks = 0; ks < D / 32; ++ks) { const bf16x8 av = *(const bf16x8*)(ap + ks * 32), bv = *(const bf16x8*)(bp + ks * 32);
            acc = __builtin_amdgcn_mfma_f32_16x16x32_bf16(av, bv, acc, 0, 0, 0); }
#pragma unroll
        for (int e = 0; e < 4; ++e) LR[(size_t)(rg * 16 + 4 * fq + e) * 16 + fr] = acc[e];
    }
}

constexpr int QE_OFF = 0, KE_OFF = 17408, KDT_OFF = 34816, VT_OFF = 53248, P_OFF = 90112, SEG_OFF = 99328, DEC_OFF = 101376, SSQ_OFF = 101888, RSTD_OFF = 103936, LRS_OFF = 104192, BC_OFF = 108288;
constexpr int QS = 136, TS = 72;

template <bool FULL>
__device__ __forceinline__ float gla_build(unsigned char* sm, const bf16_t* Hb, const float* LR, const float* wgk, const float* bgk, int m0, int h, int wid, int lane) {
    const int seg = wid >> 1, c = ((wid & 1) << 6) + lane;
    float* LRS = (float*)(sm + LRS_OFF); float* BC = (float*)(sm + BC_OFF);
    if (wid < 4) *(f32x4*)(LRS + (wid * 64 + lane) * 4) = *(const f32x4*)(LR + (size_t)m0 * 16 + (wid * 64 + lane) * 4);
    float run = 0.f;
    {
        float wg[16];
#pragma unroll
        for (int r = 0; r < 16; ++r) wg[r] = wgk[r * 512 + h * DK + c];
        const float bg = bgk[h * DK + c];
        __syncthreads();
#pragma unroll 2
        for (int i = 0; i < 16; ++i) {
            const f32x4* lr = (const f32x4*)(LRS + (seg * 16 + i) * 16);
            const f32x4 l0 = lr[0], l1 = lr[1], l2 = lr[2], l3 = lr[3];
            float z = bg;
            z += l0[0] * wg[0] + l0[1] * wg[1] + l0[2] * wg[2] + l0[3] * wg[3];
            z += l1[0] * wg[4] + l1[1] * wg[5] + l1[2] * wg[6] + l1[3] * wg[7];
            z += l2[0] * wg[8] + l2[1] * wg[9] + l2[2] * wg[10] + l2[3] * wg[11];
            z += l3[0] * wg[12] + l3[1] * wg[13] + l3[2] * wg[14] + l3[3] * wg[15];
            const float ls = fminf(z, 0.f) - __logf(1.f + __expf(-fabsf(z)));
            run += ls * (1.f / 16.f); BC[(seg * 16 + i) * 128 + c] = run;
        }
    }
    float* SEG = (float*)(sm + SEG_OFF); float* DEC = (float*)(sm + DEC_OFF);
    SEG[seg * 128 + c] = run;
    __syncthreads();
    const float s0 = SEG[c], s1 = SEG[128 + c], s2 = SEG[256 + c], s3 = SEG[384 + c];
    const float off = (seg > 0 ? s0 : 0.f) + (seg > 1 ? s1 : 0.f) + (seg > 2 ? s2 : 0.f);
    const float blast = (s0 + s1) + (s2 + s3);
    if (seg == 0) DEC[c] = __expf(blast);
    const unsigned hq0 = (unsigned)(m0 + seg * 16) * GNH + h * DK + c;
    bf16_t* QE = (bf16_t*)(sm + QE_OFF); bf16_t* KE = (bf16_t*)(sm + KE_OFF); bf16_t* KDT = (bf16_t*)(sm + KDT_OFF);
#pragma unroll 2
    for (int i = 0; i < 16; i += 2) {
        const float bc0 = off + BC[(seg * 16 + i) * 128 + c], bc1 = off + BC[(seg * 16 + i + 1) * 128 + c];
        const float kf0 = bf2f(Hb[hq0 + i * GNH + 512]), kf1 = bf2f(Hb[hq0 + (i + 1) * GNH + 512]);
        if (FULL) { const float qf0 = bf2f(Hb[hq0 + i * GNH]), qf1 = bf2f(Hb[hq0 + (i + 1) * GNH]);
            QE[(seg * 16 + i) * QS + c] = f2bf(qf0 * 0.08838834764831845f * __expf(bc0));
            KE[(seg * 16 + i) * QS + c] = f2bf(kf0 * __expf(-bc0));
            QE[(seg * 16 + i + 1) * QS + c] = f2bf(qf1 * 0.08838834764831845f * __expf(bc1));
            KE[(seg * 16 + i + 1) * QS + c] = f2bf(kf1 * __expf(-bc1)); }
        *(unsigned*)(KDT + c * TS + seg * 16 + i) = cvt_pk_bf16(kf0 * __expf(blast - bc0), kf1 * __expf(blast - bc1));
    }
    return blast;
}
__device__ __forceinline__ void gla_build_vt(unsigned char* sm, const bf16_t* Hb, int m0, int h, int tid) {
    const int dv = tid & 255, half = tid >> 8;
    const unsigned hv0 = (unsigned)(m0 + half * 32) * GNH + 1024 + h * DV + dv;
    bf16_t* VT = (bf16_t*)(sm + VT_OFF);
#pragma unroll 1
    for (int blk = 0; blk < 4; ++blk) { unsigned pk[4];
#pragma unroll
        for (int e = 0; e < 4; ++e) { const unsigned lo = Hb[hv0 + (blk * 8 + 2 * e) * GNH], hi = Hb[hv0 + (blk * 8 + 2 * e + 1) * GNH]; pk[e] = lo | (hi << 16); }
        *(u32x4*)(VT + dv * TS + half * 32 + blk * 8) = (u32x4){pk[0], pk[1], pk[2], pk[3]}; }
}
__device__ __forceinline__ void gla_update(unsigned char* sm, f32x4 (&S)[8][2], int w, int fr, int fq) {
    const float* DEC = (const float*)(sm + DEC_OFF); const bf16_t* KDT = (const bf16_t*)(sm + KDT_OFF); const bf16_t* VT = (const bf16_t*)(sm + VT_OFF);
#pragma unroll
    for (int a = 0; a < 8; ++a) { const f32x4 d4 = *(const f32x4*)(DEC + 16 * a + 4 * fq); S[a][0] *= d4; S[a][1] *= d4; }
#pragma unroll
    for (int ks = 0; ks < 2; ++ks) {
        const bf16x8 y0 = *(const bf16x8*)(VT + (32 * w + fr) * TS + 32 * ks + 8 * fq), y1 = *(const bf16x8*)(VT + (32 * w + 16 + fr) * TS + 32 * ks + 8 * fq);
#pragma unroll
        for (int a = 0; a < 8; ++a) { const bf16x8 x = *(const bf16x8*)(KDT + (16 * a + fr) * TS + 32 * ks + 8 * fq);
            S[a][0] = __builtin_amdgcn_mfma_f32_16x16x32_bf16(x, y0, S[a][0], 0, 0, 0);
            S[a][1] = __builtin_amdgcn_mfma_f32_16x16x32_bf16(x, y1, S[a][1], 0, 0, 0); }
    }
}

__device__ __forceinline__ void gla_kv_phase(const Args& a, unsigned char* sm, int j) {
    int tid = threadIdx.x; asm volatile("" : "+v"(tid));
    const int wid = __builtin_amdgcn_readfirstlane(tid >> 6), lane = tid & 63, fr = lane & 15, fq = lane >> 4, w = wid;
    const bf16_t* Hb = (const bf16_t*)(a.ws + WS_H); const float* LR = (const float*)(a.ws + WS_LR);
    float* KVG = (float*)(a.ws + WS_KVG); float* DECG = (float*)(a.ws + WS_DEC);
#pragma unroll 1
    for (int item = blockIdx.x; item < 16 * NG; item += gridDim.x) {
        const int bh = item / NG, grp = item % NG, b = bh >> 2, h = bh & 3;
        if (grp == NG - 1) continue;
        const int c = ((wid & 1) << 6) + lane;
        const float* wgk = a.in[I_GWGK] + (size_t)j * GR * 512; const float* bgk = a.in[I_GBGK] + j * 512;
        f32x4 S[8][2];
#pragma unroll
        for (int x = 0; x < 8; ++x) { S[x][0] = (f32x4){0.f, 0.f, 0.f, 0.f}; S[x][1] = (f32x4){0.f, 0.f, 0.f, 0.f}; }
        float blsum = 0.f;
#pragma unroll 1
        for (int ch = 0; ch < GC; ++ch) {
            const int m0 = b * T + (grp * GC + ch) * 64;
            { int t1 = tid; asm volatile("" : "+v"(t1)); blsum += gla_build<false>(sm, Hb, LR, wgk, bgk, m0, h, wid, t1 & 63); }
            { int t1 = tid; asm volatile("" : "+v"(t1)); gla_build_vt(sm, Hb, m0, h, t1); }
            __syncthreads();
            int t2 = tid; asm volatile("" : "+v"(t2));
            gla_update(sm, S, w, t2 & 15, (t2 >> 4) & 3);
            __syncthreads();
        }
        { f32x4* dst = (f32x4*)KVG; const unsigned i0 = (unsigned)(bh * NG + grp) * 8192u + (unsigned)(w * 16 * 64 + lane);
#pragma unroll
          for (int x = 0; x < 8; ++x)
#pragma unroll
              for (int y = 0; y < 2; ++y) dst[i0 + (x * 2 + y) * 64] = S[x][y]; }
        if (wid < 2) DECG[(size_t)(bh * NG + grp) * 128 + c] = __expf(blsum);
    }
}
__device__ __forceinline__ void gla_scan_phase(const Args& a) {
    float* KVG = (float*)(a.ws + WS_KVG); const float* DECG = (const float*)(a.ws + WS_DEC);
    const int NGT = gridDim.x * NTHREADS;
    for (int gid = blockIdx.x * NTHREADS + threadIdx.x; gid < 16 * 8192; gid += NGT) {
        const int bh = gid >> 13, u = gid & 8191, ln = u & 63, tile = u >> 6, ta = (tile & 15) >> 1, fq = ln >> 4;
        f32x4 S = (f32x4){0.f, 0.f, 0.f, 0.f};
#pragma unroll 4
        for (int g = 0; g < NG; ++g) {
            float* p = KVG + ((size_t)(bh * NG + g) * 8192 + u) * 4;
            if (g < NG - 1) {
                const f32x4 kv = *(const f32x4*)p;
                const f32x4 d4 = *(const f32x4*)(DECG + (size_t)(bh * NG + g) * 128 + 16 * ta + 4 * fq);
                *(f32x4*)p = S;
                S = d4 * S + kv;
            } else *(f32x4*)p = S;
        }
    }
}
__device__ __forceinline__ void gla_out_phase(const Args& a, unsigned char* sm, int j) {
    int tid = threadIdx.x; asm volatile("" : "+v"(tid));
    const int wid = __builtin_amdgcn_readfirstlane(tid >> 6), lane = tid & 63, w = wid;
    const bf16_t* Hb = (const bf16_t*)(a.ws + WS_H); const float* LR = (const float*)(a.ws + WS_LR);
    const float* KVG = (const float*)(a.ws + WS_KVG); bf16_t* OG = (bf16_t*)(a.ws + WS_OG);
    const bf16_t* QE = (const bf16_t*)(sm + QE_OFF); const bf16_t* KE = (const bf16_t*)(sm + KE_OFF); const bf16_t* VT = (const bf16_t*)(sm + VT_OFF);
    bf16_t* P = (bf16_t*)(sm + P_OFF); float* SSQ = (float*)(sm + SSQ_OFF); float* RSTD = (float*)(sm + RSTD_OFF);
#pragma unroll 1
    for (int item = blockIdx.x; item < 16 * NG; item += gridDim.x) {
        const int bh = item / NG, grp = item % NG, b = bh >> 2, h = bh & 3;
        const int c = ((wid & 1) << 6) + lane;
        const float* wgk = a.in[I_GWGK] + (size_t)j * GR * 512; const float* bgk = a.in[I_GBGK] + j * 512;
        const float nw0 = a.in[I_GNW][j * DV + 32 * w + (lane & 15)], nw1 = a.in[I_GNW][j * DV + 32 * w + 16 + (lane & 15)];
        f32x4 S[8][2];
        { const f32x4* src = (const f32x4*)KVG; const unsigned i0 = (unsigned)(bh * NG + grp) * 8192u + (unsigned)(w * 16 * 64 + lane);
#pragma unroll
          for (int x = 0; x < 8; ++x)
#pragma unroll
              for (int y = 0; y < 2; ++y) S[x][y] = src[i0 + (x * 2 + y) * 64]; }
#pragma unroll 1
        for (int ch = 0; ch < GC; ++ch) {
            const int m0 = b * T + (grp * GC + ch) * 64;
            { int t1 = tid; asm volatile("" : "+v"(t1)); gla_build<true>(sm, Hb, LR, wgk, bgk, m0, h, wid, t1 & 63); }
            { int t1 = tid; asm volatile("" : "+v"(t1)); gla_build_vt(sm, Hb, m0, h, t1); }
            __syncthreads();
            int t2 = tid; asm volatile("" : "+v"(t2));
            const int fr = t2 & 15, fq = (t2 >> 4) & 3;
            { const int ti = w >> 1;
#pragma unroll
              for (int q = 0; q < 2; ++q) { const int tj = (w & 1) * 2 + q; f32x4 pa = (f32x4){0.f, 0.f, 0.f, 0.f};
                  if (tj <= ti) {
#pragma unroll
                      for (int ks = 0; ks < 4; ++ks) { const bf16x8 xk = *(const bf16x8*)(KE + (16 * tj + fr) * QS + 32 * ks + 8 * fq), yq = *(const bf16x8*)(QE + (16 * ti + fr) * QS + 32 * ks + 8 * fq);
                          pa = __builtin_amdgcn_mfma_f32_16x16x32_bf16(xk, yq, pa, 0, 0, 0); } }
                  const int i = 16 * ti + fr, jb = 16 * tj + 4 * fq;
#pragma unroll
                  for (int e = 0; e < 4; ++e) if (jb + e > i) pa[e] = 0.f;
                  *(u32x2*)(P + i * TS + jb) = (u32x2){cvt_pk_bf16(pa[0], pa[1]), cvt_pk_bf16(pa[2], pa[3])}; } }
            __syncthreads();
            f32x4 O[4][2];
#pragma unroll
            for (int ti = 0; ti < 4; ++ti) { O[ti][0] = (f32x4){0.f, 0.f, 0.f, 0.f}; O[ti][1] = (f32x4){0.f, 0.f, 0.f, 0.f}; }
#pragma unroll
            for (int ks = 0; ks < 2; ++ks) {
                const bf16x8 y0 = *(const bf16x8*)(VT + (32 * w + fr) * TS + 32 * ks + 8 * fq), y1 = *(const bf16x8*)(VT + (32 * w + 16 + fr) * TS + 32 * ks + 8 * fq);
#pragma unroll
                for (int ti = 0; ti < 4; ++ti) { const bf16x8 x = *(const bf16x8*)(P + (16 * ti + fr) * TS + 32 * ks + 8 * fq);
                    O[ti][0] = __builtin_amdgcn_mfma_f32_16x16x32_bf16(x, y0, O[ti][0], 0, 0, 0);
                    O[ti][1] = __builtin_amdgcn_mfma_f32_16x16x32_bf16(x, y1, O[ti][1], 0, 0, 0); }
            }
#pragma unroll
            for (int kk = 0; kk < 4; ++kk) {
                bf16x8 ys[2];
#pragma unroll
                for (int y = 0; y < 2; ++y) { const f32x4 sa = S[2 * kk][y], sb = S[2 * kk + 1][y];
                    const u32x4 pk = (u32x4){cvt_pk_bf16(sa[0], sa[1]), cvt_pk_bf16(sa[2], sa[3]), cvt_pk_bf16(sb[0], sb[1]), cvt_pk_bf16(sb[2], sb[3])};
                    ys[y] = __builtin_bit_cast(bf16x8, pk); }
#pragma unroll
                for (int ti = 0; ti < 4; ++ti) {
                    const u32x2 lo = *(const u32x2*)(QE + (16 * ti + fr) * QS + 32 * kk + 4 * fq), hi = *(const u32x2*)(QE + (16 * ti + fr) * QS + 32 * kk + 16 + 4 * fq);
                    const bf16x8 x = __builtin_bit_cast(bf16x8, ((u32x4){lo.x, lo.y, hi.x, hi.y}));
                    O[ti][0] = __builtin_amdgcn_mfma_f32_16x16x32_bf16(x, ys[0], O[ti][0], 0, 0, 0);
                    O[ti][1] = __builtin_amdgcn_mfma_f32_16x16x32_bf16(x, ys[1], O[ti][1], 0, 0, 0); }
            }
            gla_update(sm, S, w, fr, fq);
#pragma unroll
            for (int ti = 0; ti < 4; ++ti)
#pragma unroll
                for (int e = 0; e < 4; ++e) { float p = O[ti][0][e] * O[ti][0][e] + O[ti][1][e] * O[ti][1][e];
                    p += __shfl_xor(p, 1); p += __shfl_xor(p, 2); p += __shfl_xor(p, 4); p += __shfl_xor(p, 8);
                    if (fr == 0) SSQ[w * 64 + 16 * ti + 4 * fq + e] = p; }
            __syncthreads();
            if (tid < 64) { float s = 0.f;
#pragma unroll
                for (int ww = 0; ww < 8; ++ww) s += SSQ[ww * 64 + tid];
                RSTD[tid] = rsqrtf(s * (1.f / DV) + RMS_EPS); }
            __syncthreads();
            int t3 = tid; asm volatile("" : "+v"(t3));
            const int fr3 = t3 & 15, fq3 = (t3 >> 4) & 3;
#pragma unroll
            for (int ti = 0; ti < 4; ++ti) {
                asm volatile("" ::: "memory");
#pragma unroll
                for (int e = 0; e < 4; ++e) { const int i = 16 * ti + 4 * fq3 + e; const float r = RSTD[i];
                    const unsigned gi = (unsigned)(m0 + i) * GNH + 2048 + h * DV + 32 * w + fr3;
                    const unsigned oi = (unsigned)(m0 + i) * D + h * DV + 32 * w + fr3;
                    OG[oi] = f2bf(O[ti][0][e] * r * nw0 * silu_f(bf2f(Hb[gi])));
                    OG[oi + 16] = f2bf(O[ti][1][e] * r * nw1 * silu_f(bf2f(Hb[gi + 16]))); } }
        }
    }
}

__device__ __forceinline__ void ln_phase(float* X, bf16_t* XB, const float* g, const float* bta) {
    int tid = threadIdx.x; asm volatile("" : "+v"(tid));
    const int wid = __builtin_amdgcn_readfirstlane(tid >> 6), lane = tid & 63;
    const int gw = blockIdx.x * 8 + wid, NGW = gridDim.x * 8;
    f32x4 gv[4], bv[4];
#pragma unroll
    for (int jj = 0; jj < 4; ++jj) { gv[jj] = *(const f32x4*)(g + 4 * lane + 256 * jj); bv[jj] = *(const f32x4*)(bta + 4 * lane + 256 * jj); }
    for (int m = gw; m < M; m += NGW) {
        f32x4* xr = (f32x4*)(X + (size_t)m * D) + lane;
        f32x4 v[4]; float s = 0.f;
#pragma unroll
        for (int jj = 0; jj < 4; ++jj) { v[jj] = xr[64 * jj]; s += (v[jj][0] + v[jj][1]) + (v[jj][2] + v[jj][3]); }
        const float mean = wave_sum(s) * (1.f / D); float s2 = 0.f;
#pragma unroll
        for (int jj = 0; jj < 4; ++jj) { v[jj] = v[jj] - mean; s2 += (v[jj][0] * v[jj][0] + v[jj][1] * v[jj][1]) + (v[jj][2] * v[jj][2] + v[jj][3] * v[jj][3]); }
        const float rstd = rsqrtf(wave_sum(s2) * (1.f / D) + LN_EPS);
        u32x2* ob = (u32x2*)(XB + (size_t)m * D) + lane;
#pragma unroll
        for (int jj = 0; jj < 4; ++jj) { const f32x4 y = v[jj] * rstd * gv[jj] + bv[jj]; xr[64 * jj] = y;
            ob[64 * jj] = (u32x2){cvt_pk_bf16(y[0], y[1]), cvt_pk_bf16(y[2], y[3])}; }
    }
}

__device__ __forceinline__ void pool_phase(const bf16_t* U, bf16_t* Pp) {
    int tid = threadIdx.x; asm volatile("" : "+v"(tid));
    const int vc = tid & 255, half = tid >> 8, win = 2 << (vc >> 6);
    for (int seg = blockIdx.x; seg < M / 64; seg += gridDim.x) {
        const int mbase = seg * 64 + half * 32;
        const int t0 = mbase & (T - 1);
        const bf16_t* up = U + (size_t)mbase * PW + vc * 8;
        bf16_t* pp = Pp + (size_t)mbase * PW + vc * 8;
        float sum[8];
#pragma unroll
        for (int e = 0; e < 8; ++e) sum[e] = 0.f;
        for (int d = 1; d < win; ++d) if (t0 - d >= 0) { const u32x4 q = *(const u32x4*)(up - (size_t)d * PW);
            sum[0] += bflo(q.x); sum[1] += bfhi(q.x); sum[2] += bflo(q.y); sum[3] += bfhi(q.y); sum[4] += bflo(q.z); sum[5] += bfhi(q.z); sum[6] += bflo(q.w); sum[7] += bfhi(q.w); }
        for (int i = 0; i < 32; ++i) {
            const int t = t0 + i;
            const u32x4 q = *(const u32x4*)(up + (size_t)i * PW);
            float u8[8] = {bflo(q.x), bfhi(q.x), bflo(q.y), bfhi(q.y), bflo(q.z), bfhi(q.z), bflo(q.w), bfhi(q.w)};
            const float inv = 1.f / (float)min(t + 1, win);
            float o[8];
#pragma unroll
            for (int e = 0; e < 8; ++e) { sum[e] += u8[e]; o[e] = sum[e] * inv - u8[e]; }
            *(u32x4*)(pp + (size_t)i * PW) = (u32x4){cvt_pk_bf16(o[0], o[1]), cvt_pk_bf16(o[2], o[3]), cvt_pk_bf16(o[4], o[5]), cvt_pk_bf16(o[6], o[7])};
            if (t - win + 1 >= 0) { const u32x4 r = *(const u32x4*)(up + (size_t)(i - win + 1) * PW);
                sum[0] -= bflo(r.x); sum[1] -= bfhi(r.x); sum[2] -= bflo(r.y); sum[3] -= bfhi(r.y); sum[4] -= bflo(r.z); sum[5] -= bfhi(r.z); sum[6] -= bflo(r.w); sum[7] -= bfhi(r.w); }
        }
    }
}

typedef const __attribute__((address_space(4))) Args* ArgP;
__device__ __forceinline__ ArgP argp() { ArgP p = (ArgP)__builtin_amdgcn_kernarg_segment_ptr(); asm volatile("" : "+s"(p)); return p; }
__device__ __forceinline__ Args argv() { ArgP p = argp(); Args a;
#pragma unroll
    for (int i = 0; i < 13; ++i) a.in[i] = p->in[i];
    a.out = p->out; a.ws = p->ws; return a; }

__global__ void __launch_bounds__(NTHREADS, 2) mega_fwd(Args a_unused) {
    extern __shared__ __attribute__((aligned(16))) unsigned char smem[];
    cg::grid_group grid = cg::this_grid();
    LAS unsigned char* lds = (LAS unsigned char*)smem;

    { const Args a = argv(); int tid = threadIdx.x; asm volatile("" : "+v"(tid));
      prologue_phase(a, smem, __builtin_amdgcn_readfirstlane(tid >> 6), tid & 63); }
    grid.sync();

#pragma unroll 1
    for (int L = 0; L < 4; ++L) {
        const int j = L >> 1;
        if ((L & 1) == 0) {
            { ArgP p = argp(); unsigned char* ws = p->ws; unsigned char* wsw = ws + WS_W;
              pg8::Gemm g{(const bf16_t*)(ws + WS_XB), (const bf16_t*)(wsw + W_GIN + j * W_GIN_SZ), M, GNH, D, D, 1 << 30, 0}; pg8::StaticOrder S; S.init(M, GNH, gridDim.x, (int)blockIdx.x);
              pg8::EpiBf16 E{(bf16_t*)(ws + WS_H), GNH, 0, 0};
              pg8::gemm_phase(lds, g, S, E); }
            { ArgP p = argp(); unsigned char* ws = p->ws; unsigned char* wsw = ws + WS_W; int tid = threadIdx.x; asm volatile("" : "+v"(tid));
              lr_phase((const bf16_t*)(ws + WS_XB), (const bf16_t*)(wsw + W_LR + j * W_LR_SZ), (float*)(ws + WS_LR), __builtin_amdgcn_readfirstlane(tid >> 6), tid & 63); }
            grid.sync();
            { const Args a = argv(); gla_kv_phase(a, smem, j); }
            grid.sync();
            { const Args a = argv(); gla_scan_phase(a); }
            grid.sync();
            { const Args a = argv(); gla_out_phase(a, smem, j); }
            grid.sync();
            { ArgP p = argp(); unsigned char* ws = p->ws; unsigned char* wsw = ws + WS_W; float* out = p->out; const float* base = (L == 0) ? p->in[I_X] : out;
              pg8::Gemm g{(const bf16_t*)(ws + WS_OG), (const bf16_t*)(wsw + W_GOUT + j * W_GOUT_SZ), M, D, D, D, 1 << 30, 0}; pg8::StaticOrder S; S.init(M, D, gridDim.x, (int)blockIdx.x);
              pg8::EpiRes E{base, out, D};
              pg8::gemm_phase(lds, g, S, E); }
        } else {
            { ArgP p = argp(); unsigned char* ws = p->ws; unsigned char* wsw = ws + WS_W;
              pg8::Gemm g{(const bf16_t*)(ws + WS_XB), (const bf16_t*)(wsw + W_PIN + j * W_PIN_SZ), M, 4096, D, D, 1 << 30, 0}; pg8::StaticOrder S; S.init(M, 4096, gridDim.x, (int)blockIdx.x);
              pg8::EpiBf16 E{(bf16_t*)(ws + WS_H), PW, PW, (size_t)(WS_Z - WS_H) / 2};
              pg8::gemm_phase(lds, g, S, E); }
            grid.sync();
            { ArgP p = argp(); unsigned char* ws = p->ws; pool_phase((const bf16_t*)(ws + WS_H), (bf16_t*)(ws + WS_P)); }
            grid.sync();
            { ArgP p = argp(); unsigned char* ws = p->ws; unsigned char* wsw = ws + WS_W;
              pg8::Gemm g{(const bf16_t*)(ws + WS_P), (const bf16_t*)(wsw + W_PGRP + j * W_PGRP_SZ), M, PW, 512, PW, 2, 512}; pg8::StaticOrder S; S.init(M, PW, gridDim.x, (int)blockIdx.x);
              pg8::EpiPool E{(bf16_t*)(ws + WS_Y), (const bf16_t*)(ws + WS_Z), p->in[I_PBGRP] + j * PW, p->in[I_PSCALE] + j * PW};
              pg8::gemm_phase(lds, g, S, E); }
            grid.sync();
            { ArgP p = argp(); unsigned char* ws = p->ws; unsigned char* wsw = ws + WS_W; float* out = p->out; const float* base = out;
              pg8::Gemm g{(const bf16_t*)(ws + WS_Y), (const bf16_t*)(wsw + W_POUT + j * W_POUT_SZ), M, D, PW, PW, 1 << 30, 0}; pg8::StaticOrder S; S.init(M, D, gridDim.x, (int)blockIdx.x);
              pg8::EpiRes E{base, out, D};
              pg8::gemm_phase(lds, g, S, E); }
        }
        grid.sync();
        { ArgP p = argp(); ln_phase(p->out, (bf16_t*)(p->ws + WS_XB), p->in[I_LNG] + L * D, p->in[I_LNB] + L * D); }
        if (L < 3) grid.sync();
    }
}

extern "C" void kernel_launch(void* const* d_in, const int* in_sizes, int n_in, void* d_out, int out_size, void* d_ws, size_t ws_size, hipStream_t stream) {
    static int grid_blocks = 0;
    if (!grid_blocks) {
        int dev = 0, cus = 0, per_cu = 0;
        hipGetDevice(&dev);
        hipDeviceGetAttribute(&cus, hipDeviceAttributeMultiprocessorCount, dev);
        hipFuncSetAttribute((const void*)mega_fwd, hipFuncAttributeMaxDynamicSharedMemorySize, LDS_BYTES);
        hipOccupancyMaxActiveBlocksPerMultiprocessor(&per_cu, (const void*)mega_fwd, NTHREADS, LDS_BYTES);
        if (per_cu < 1) per_cu = 1;
        if (per_cu > 1) per_cu = 1;
        grid_blocks = cus * per_cu;
        if (grid_blocks > 256) grid_blocks = 256;
    }
    Args a{};
    for (int i = 0; i < 13; ++i) a.in[i] = (const float*)d_in[i];
    a.out = (float*)d_out; a.ws = (unsigned char*)d_ws;
    void* args[] = {&a};
    hipError_t e = hipLaunchCooperativeKernel((void*)mega_fwd, dim3(grid_blocks), dim3(NTHREADS), args, LDS_BYTES, stream);
    if (e != hipSuccess) fprintf(stderr, "cooperative launch failed: %s (grid %d)\n", hipGetErrorString(e), grid_blocks);
}
```

```cpp
#include <hip/hip_runtime.h>
#include <hip/hip_cooperative_groups.h>
#include <cstdio>
namespace cg = cooperative_groups;

#define LAS __attribute__((address_space(3)))
typedef unsigned short bf16_t;
typedef short bf16x8 __attribute__((ext_vector_type(8)));
typedef float f32x4 __attribute__((ext_vector_type(4)));
typedef unsigned u32x4 __attribute__((ext_vector_type(4)));
typedef unsigned u32x2 __attribute__((ext_vector_type(2)));

constexpr int M = 16384, D = 1024, T = 4096;
constexpr int GH = 4, DK = 128, DV = 256, GR = 16, GNIN = 3088, GNH = 3072;
constexpr int GC = 4, NG = 16;
constexpr int PW = 2048;
constexpr float ALPHA = 1.6817928305074292f;
constexpr float LN_EPS = 1e-5f, RMS_EPS = 1e-6f;
constexpr int NTHREADS = 512;
constexpr int LDS_BYTES = 147456;

constexpr size_t MiB = 1u << 20;
constexpr size_t WS_W = 1 * MiB;
constexpr size_t W_GIN = 0, W_GIN_SZ = (size_t)GNH * D * 2;
constexpr size_t W_GOUT = 2 * W_GIN_SZ, W_GOUT_SZ = (size_t)D * D * 2;
constexpr size_t W_PIN = W_GOUT + 2 * W_GOUT_SZ, W_PIN_SZ = (size_t)4096 * D * 2;
constexpr size_t W_PGRP = W_PIN + 2 * W_PIN_SZ, W_PGRP_SZ = (size_t)2048 * 512 * 2;
constexpr size_t W_POUT = W_PGRP + 2 * W_PGRP_SZ, W_POUT_SZ = (size_t)D * 2048 * 2;
constexpr size_t W_LR = W_POUT + 2 * W_POUT_SZ, W_LR_SZ = (size_t)16 * D * 2;
constexpr size_t W_END = W_LR + 2 * W_LR_SZ;
static_assert(WS_W + W_END <= 48 * MiB, "weights");
constexpr size_t WS_XB = 48 * MiB;
constexpr size_t WS_OG = 48 * MiB;
constexpr size_t WS_P = 48 * MiB;
constexpr size_t WS_LR = 80 * MiB;
constexpr size_t WS_DEC = 81 * MiB;
constexpr size_t WS_H = 112 * MiB;
constexpr size_t WS_Z = 176 * MiB;
constexpr size_t WS_KVG = 208 * MiB;
constexpr size_t WS_Y = 112 * MiB;

__device__ __forceinline__ unsigned cvt_pk_bf16(float lo, float hi) { unsigned r; asm volatile("v_cvt_pk_bf16_f32 %0, %1, %2" : "=v"(r) : "v"(lo), "v"(hi)); return r; }
__device__ __forceinline__ bf16_t f2bf(float f) { return (bf16_t)(cvt_pk_bf16(f, 0.f) & 0xffffu); }
__device__ __forceinline__ float bf2f(bf16_t b) { return __uint_as_float(((unsigned)b) << 16); }
__device__ __forceinline__ float bflo(unsigned w) { return __uint_as_float(w << 16); }
__device__ __forceinline__ float bfhi(unsigned w) { return __uint_as_float(w & 0xffff0000u); }
__device__ __forceinline__ float silu_f(float z) { return z / (1.f + __expf(-z)); }
__device__ __forceinline__ float wave_sum(float v) {
#pragma unroll
    for (int o = 1; o < 64; o <<= 1) v += __shfl_xor(v, o);
    return v;
}

namespace pg8 {
constexpr int BM = 256, BK = 64, HALF = 128, HTB = HALF * BK * 2, STAGE_BYTES = 8 * HTB, NXCD = 8, WGM = 8;
__host__ __device__ __forceinline__ int lds_byte(int r, int c) { const int st = (r >> 4) * 2 + (c >> 5), rr = r & 15, cc = c & 31, ob = rr * 64 + cc * 2; return st * 1024 + (ob ^ (((ob >> 9) & 1) << 5)); }
__host__ __device__ __forceinline__ void stage_rc(int b, int& R, int& C) { const int st = b / 1024, sb = b % 1024, swz = sb ^ (((sb >> 9) & 1) << 5); R = (st >> 1) * 16 + swz / 64; C = (st & 1) * 32 + (swz % 64) / 2; }
__host__ __device__ __forceinline__ int perm32(int rho) { const int n = rho >> 4, i = rho & 15; return 8 * (i >> 2) + 4 * n + (i & 3); }

struct Unit { int pm, pn; };
struct Gemm { const bf16_t* A; const bf16_t* Bt; int M, N, K, lda, grp_div, grp_off; };

struct StaticOrder {
    int nM, nN, nwg, G, c;
    __device__ void init(int M_, int N_, int G_, int c_) { nM = M_ / BM; nN = N_ / BM; nwg = nM * nN; G = G_; c = c_; }
    __device__ bool next(int i, Unit& u) const {
        const long L = (long)i * G + c; if (L >= nwg) return false;
        int wgid = (int)L; { const int q = nwg / NXCD, r = nwg % NXCD, xcd = wgid % NXCD, off = wgid / NXCD; wgid = (xcd < r ? xcd * (q + 1) : r * (q + 1) + (xcd - r) * q) + off; }
        const int nig = WGM * nN, gid = wgid / nig, fm = gid * WGM, gsz = (nM - fm) < WGM ? (nM - fm) : WGM;
        u.pm = fm + ((wgid % nig) % gsz); u.pn = (wgid % nig) / gsz; return true;
    }
};

struct EpiBf16 {
    static constexpr bool PERM = true;
    bf16_t* O; int ldc; int split_cols; size_t split_stride;
    __device__ __forceinline__ void operator()(const f32x4 (&acc)[2][2][4][2], const Unit& u, int wr, int wc, int fr, int fq) const {
        const int row0 = u.pm * BM + wr * 64 + fr; int colt = u.pn * BM; bf16_t* base = O;
        if (split_cols) { const int t = colt / split_cols; base += (size_t)t * split_stride; colt -= t * split_cols; }
        const int col0 = colt + wc * 32 + 8 * fq;
#pragma unroll
        for (int ai = 0; ai < 2; ++ai)
#pragma unroll
            for (int m = 0; m < 4; ++m) { bf16_t* rowp = base + (size_t)(row0 + ai * HALF + m * 16) * ldc + col0;
#pragma unroll
                for (int bj = 0; bj < 2; ++bj) { const f32x4 v0 = acc[ai][bj][m][0], v1 = acc[ai][bj][m][1];
                    u32x4 w; w.x = cvt_pk_bf16(v0[0], v0[1]); w.y = cvt_pk_bf16(v0[2], v0[3]); w.z = cvt_pk_bf16(v1[0], v1[1]); w.w = cvt_pk_bf16(v1[2], v1[3]);
                    *(u32x4*)(rowp + bj * HALF) = w; } }
    }
};
struct EpiRes {
    static constexpr bool PERM = false;
    const float* base; float* out; int ldc;
    __device__ __forceinline__ void operator()(const f32x4 (&acc)[2][2][4][2], const Unit& u, int wr, int wc, int fr, int fq) const {
        const int row0 = u.pm * BM + wr * 64 + fr, col0 = u.pn * BM + wc * 32 + 4 * fq;
#pragma unroll
        for (int ai = 0; ai < 2; ++ai)
#pragma unroll
            for (int m = 0; m < 4; ++m) { const size_t off = (size_t)(row0 + ai * HALF + m * 16) * ldc + col0;
#pragma unroll
                for (int bj = 0; bj < 2; ++bj)
#pragma unroll
                    for (int n = 0; n < 2; ++n) { const f32x4 bs = *(const f32x4*)(base + off + bj * HALF + n * 16);
                        *(f32x4*)(out + off + bj * HALF + n * 16) = bs * ALPHA + acc[ai][bj][m][n]; } }
    }
};
struct EpiPool {
    static constexpr bool PERM = true;
    bf16_t* Y; const bf16_t* Z; const float* bias; const float* scale;
    __device__ __forceinline__ void operator()(const f32x4 (&acc)[2][2][4][2], const Unit& u, int wr, int wc, int fr, int fq) const {
        const int row0 = u.pm * BM + wr * 64 + fr, col0 = u.pn * BM + wc * 32 + 8 * fq;
        f32x4 bv[2][2], sv[2][2];
#pragma unroll
        for (int bj = 0; bj < 2; ++bj)
#pragma unroll
            for (int n = 0; n < 2; ++n) { bv[bj][n] = *(const f32x4*)(bias + col0 + bj * HALF + 4 * n); sv[bj][n] = *(const f32x4*)(scale + col0 + bj * HALF + 4 * n); }
#pragma unroll
        for (int ai = 0; ai < 2; ++ai)
#pragma unroll
            for (int m = 0; m < 4; ++m) { const size_t off = (size_t)(row0 + ai * HALF + m * 16) * PW + col0;
#pragma unroll
                for (int bj = 0; bj < 2; ++bj) {
                    const u32x4 zz = *(const u32x4*)(Z + off + bj * HALF);
                    f32x4 v0 = (acc[ai][bj][m][0] + bv[bj][0]) * sv[bj][0], v1 = (acc[ai][bj][m][1] + bv[bj][1]) * sv[bj][1];
                    v0[0] *= silu_f(bflo(zz.x)); v0[1] *= silu_f(bfhi(zz.x)); v0[2] *= silu_f(bflo(zz.y)); v0[3] *= silu_f(bfhi(zz.y));
                    v1[0] *= silu_f(bflo(zz.z)); v1[1] *= silu_f(bfhi(zz.z)); v1[2] *= silu_f(bflo(zz.w)); v1[3] *= silu_f(bfhi(zz.w));
                    u32x4 w; w.x = cvt_pk_bf16(v0[0], v0[1]); w.y = cvt_pk_bf16(v0[2], v0[3]); w.z = cvt_pk_bf16(v1[0], v1[1]); w.w = cvt_pk_bf16(v1[2], v1[3]);
                    *(u32x4*)(Y + off + bj * HALF) = w; } }
    }
};

template <class Epi, class Sched>
__device__ __forceinline__ void gemm_phase(LAS unsigned char* lds, const Gemm g, const Sched& S, const Epi& E) {
    int tid = threadIdx.x; asm volatile("" : "+v"(tid));
    const int wid = __builtin_amdgcn_readfirstlane(tid >> 6), lane = tid & 63, wr = wid >> 2, wc = wid & 3, fr = lane & 15, fq = lane >> 4;
    const int K = g.K, nt = K / BK, lda = g.lda;
    unsigned voffA[2], voffB[2];
#pragma unroll
    for (int i = 0; i < 2; ++i) { int R, C; stage_rc(tid * 16 + i * 8192, R, C); const int Rb = Epi::PERM ? ((R & ~31) + perm32(R & 31)) : R;
        voffA[i] = (unsigned)(R * lda + C) * 2u; voffB[i] = (unsigned)(Rb * K + C) * 2u; }
    const size_t kstep = (size_t)(BK * 2);
    const size_t hstepA = (size_t)HALF * lda * 2, hstepB = (size_t)HALF * K * 2;
    const size_t tstepA = 2 * hstepA, tstepB = 2 * hstepB;
    const unsigned ldsw = (unsigned)wid * 1024u;
    const int aoff = lds_byte(wr * 64 + fr, fq * 8), boff = lds_byte(wc * 32 + fr, fq * 8);
#define PG8_SA(b, h) (((b) * 2 + (h)) * HTB)
#define PG8_SB(b, h) ((4 + (b) * 2 + (h)) * HTB)
#define PG8_STAGE(bufoff, gbase, voff) do { _Pragma("unroll") for (int _i = 0; _i < 2; ++_i) \
        __builtin_amdgcn_global_load_lds((const unsigned*)((const char*)(gbase) + (voff)[_i]), (LAS unsigned*)(lds + (bufoff) + ldsw + _i * 8192), 16, 0, 0); } while (0)
#define PG8_LDA(dst, b, h) do { _Pragma("unroll") for (int m = 0; m < 4; ++m) _Pragma("unroll") for (int k = 0; k < 2; ++k) dst[m][k] = *(const LAS bf16x8*)(lds + PG8_SA(b, h) + aoff + m * 2048 + k * 1024); } while (0)
#define PG8_LDB(dst, b, h) do { _Pragma("unroll") for (int n = 0; n < 2; ++n) _Pragma("unroll") for (int k = 0; k < 2; ++k) dst[n][k] = *(const LAS bf16x8*)(lds + PG8_SB(b, h) + boff + n * 2048 + k * 1024); } while (0)
#define PG8_MMA(ai, bj, At, Bt) do { __builtin_amdgcn_s_setprio(1); _Pragma("unroll") for (int m = 0; m < 4; ++m) _Pragma("unroll") for (int n = 0; n < 2; ++n) _Pragma("unroll") for (int k = 0; k < 2; ++k) \
        acc[ai][bj][m][n] = __builtin_amdgcn_mfma_f32_16x16x32_bf16(Bt[n][k], At[m][k], acc[ai][bj][m][n], 0, 0, 0); __builtin_amdgcn_s_setprio(0); } while (0)
#define PG8_WAIT_V(n) asm volatile("s_waitcnt vmcnt(" #n ")" ::: "memory")
#define PG8_WAIT_L(n) asm volatile("s_waitcnt lgkmcnt(" #n ")" ::: "memory")
#define PG8_BAR __builtin_amdgcn_s_barrier()
#define PG8_SCHED __builtin_amdgcn_sched_barrier(0)
    Unit cur, nxt; int ui = 0;
    if (!S.next(0, cur)) return;
    f32x4 acc[2][2][4][2];
#pragma unroll
    for (int a = 0; a < 2; ++a)
#pragma unroll
        for (int b = 0; b < 2; ++b)
#pragma unroll
            for (int m = 0; m < 4; ++m)
#pragma unroll
                for (int n = 0; n < 2; ++n) acc[a][b][m][n] = (f32x4){0.f, 0.f, 0.f, 0.f};
    bf16x8 At[4][2], B0[2][2], B1[2][2];
    const char* cA = (const char*)g.A + (size_t)cur.pm * tstepA + (size_t)(cur.pn / g.grp_div) * g.grp_off * 2; const char* cB = (const char*)g.Bt + (size_t)cur.pn * tstepB;
    PG8_STAGE(PG8_SB(0, 0), cB, voffB); PG8_STAGE(PG8_SA(0, 0), cA, voffA); PG8_STAGE(PG8_SB(0, 1), cB + hstepB, voffB); PG8_STAGE(PG8_SA(0, 1), cA + hstepA, voffA);
    if (wr == 1) PG8_BAR;
    PG8_WAIT_V(4); PG8_BAR;
    PG8_STAGE(PG8_SB(1, 0), cB + kstep, voffB); PG8_STAGE(PG8_SA(1, 0), cA + kstep, voffA); PG8_STAGE(PG8_SB(1, 1), cB + hstepB + kstep, voffB);
    PG8_WAIT_V(6); PG8_BAR;
    for (;;) {
        const bool has_next = S.next(ui + 1, nxt);
        const char* nA = has_next ? (const char*)g.A + (size_t)nxt.pm * tstepA + (size_t)(nxt.pn / g.grp_div) * g.grp_off * 2 : cA; const char* nB = has_next ? (const char*)g.Bt + (size_t)nxt.pn * tstepB : cB;
        for (int t = 0; t < nt; t += 2) {
            const bool last = (t == nt - 2);
            const char* a1 = cA + (size_t)(t + 1) * kstep;
            const char* a2 = last ? nA : cA + (size_t)(t + 2) * kstep; const char* b2 = last ? nB : cB + (size_t)(t + 2) * kstep;
            const char* a3 = a2 + kstep; const char* b3 = b2 + kstep;
            PG8_LDB(B0, 0, 0); PG8_SCHED; PG8_LDA(At, 0, 0); PG8_STAGE(PG8_SA(1, 1), a1 + hstepA, voffA);
            PG8_WAIT_L(8); PG8_BAR; PG8_WAIT_L(0); PG8_MMA(0, 0, At, B0); PG8_BAR; PG8_SCHED;
            PG8_LDB(B1, 0, 1); PG8_STAGE(PG8_SB(0, 0), b2, voffB);
            PG8_BAR; PG8_WAIT_L(0); PG8_MMA(0, 1, At, B1); PG8_BAR;
            PG8_LDA(At, 0, 1); PG8_STAGE(PG8_SA(0, 0), a2, voffA);
            PG8_BAR; PG8_WAIT_L(0); PG8_MMA(1, 0, At, B0); PG8_BAR; PG8_SCHED;
            PG8_STAGE(PG8_SB(0, 1), b2 + hstepB, voffB);
            PG8_WAIT_V(6); PG8_BAR; PG8_MMA(1, 1, At, B1); PG8_BAR;
            PG8_LDB(B0, 1, 0); PG8_SCHED; PG8_LDA(At, 1, 0); PG8_STAGE(PG8_SA(0, 1), a2 + hstepA, voffA);
            PG8_WAIT_L(8); PG8_BAR; PG8_WAIT_L(0); PG8_MMA(0, 0, At, B0); PG8_BAR; PG8_SCHED;
            PG8_LDB(B1, 1, 1); PG8_STAGE(PG8_SB(1, 0), b3, voffB);
            PG8_BAR; PG8_WAIT_L(0); PG8_MMA(0, 1, At, B1); PG8_BAR;
            PG8_LDA(At, 1, 1); PG8_STAGE(PG8_SA(1, 0), a3, voffA);
            PG8_BAR; PG8_WAIT_L(0); PG8_MMA(1, 0, At, B0); PG8_BAR; PG8_SCHED;
            PG8_STAGE(PG8_SB(1, 1), b3 + hstepB, voffB);
            PG8_WAIT_V(6); PG8_BAR; PG8_MMA(1, 1, At, B1); PG8_BAR;
        }
        E(acc, cur, wr, wc, fr, fq);
        if (!has_next) break;
#pragma unroll
        for (int a = 0; a < 2; ++a)
#pragma unroll
            for (int b = 0; b < 2; ++b)
#pragma unroll
                for (int m = 0; m < 4; ++m)
#pragma unroll
                    for (int n = 0; n < 2; ++n) acc[a][b][m][n] = (f32x4){0.f, 0.f, 0.f, 0.f};
        cur = nxt; cA = nA; cB = nB; ++ui;
    }
    PG8_WAIT_V(0);
    if (wr == 0) PG8_BAR;
    PG8_BAR;
#undef PG8_SA
#undef PG8_SB
#undef PG8_STAGE
#undef PG8_LDA
#undef PG8_LDB
#undef PG8_MMA
#undef PG8_WAIT_V
#undef PG8_WAIT_L
#undef PG8_BAR
#undef PG8_SCHED
}
}

struct Args { const float* in[13]; float* out; unsigned char* ws; };
enum { I_X = 0, I_GWIN, I_GWGK, I_GBGK, I_GNW, I_GWOUT, I_PWIN, I_PWGRP, I_PBGRP, I_PSCALE, I_PWOUT, I_LNG, I_LNB };

__device__ __forceinline__ void transpose_item(const float* W, int ldw, int K, int N, bf16_t* WT, int row_off, float* scr, int item, int lane) {
    const int nblk = N / 32, kb = item / nblk, nb = item % nblk, k0 = 64 * kb, n0 = 32 * nb;
#pragma unroll 8
    for (int i = 0; i < 32; ++i) { const int kk = 2 * i + (lane >> 5); scr[kk * 33 + (lane & 31)] = W[(size_t)(k0 + kk) * ldw + n0 + (lane & 31)]; }
    asm volatile("s_waitcnt lgkmcnt(0)" ::: "memory");
    const int c = lane & 7;
#pragma unroll
    for (int j = 0; j < 4; ++j) { const int n = (lane >> 3) + 8 * j; const float* s = scr + (8 * c) * 33 + n;
        u32x4 o; o.x = cvt_pk_bf16(s[0 * 33], s[1 * 33]); o.y = cvt_pk_bf16(s[2 * 33], s[3 * 33]); o.z = cvt_pk_bf16(s[4 * 33], s[5 * 33]); o.w = cvt_pk_bf16(s[6 * 33], s[7 * 33]);
        *(u32x4*)(WT + (size_t)(row_off + n0 + n) * K + k0 + 8 * c) = o; }
    asm volatile("s_waitcnt lgkmcnt(0)" ::: "memory");
}

__device__ __forceinline__ void prologue_phase(const Args& a, unsigned char* smem, int wid, int lane) {
    unsigned char* wsw = a.ws + WS_W;
    float* scr = (float*)(smem + wid * 16384);
    const int gw = blockIdx.x * 8 + wid, NGW = gridDim.x * 8;
    constexpr int I_A = 16 * 96, I_B = 16 * 32, I_C = 16 * 128, I_D = 8 * 16, I_E = 32 * 32;
    constexpr int PER_J = I_A + I_B + I_C + 4 * I_D + I_E;
    for (int it = gw; it < 2 * PER_J; it += NGW) {
        const int j = it / PER_J; int r = it % PER_J;
        if (r < I_A) { transpose_item(a.in[I_GWIN] + (size_t)j * D * GNIN, GNIN, D, GNH, (bf16_t*)(wsw + W_GIN + j * W_GIN_SZ), 0, scr, r, lane); continue; } r -= I_A;
        if (r < I_B) { transpose_item(a.in[I_GWOUT] + (size_t)j * D * D, D, D, D, (bf16_t*)(wsw + W_GOUT + j * W_GOUT_SZ), 0, scr, r, lane); continue; } r -= I_B;
        if (r < I_C) { transpose_item(a.in[I_PWIN] + (size_t)j * D * 4096, 4096, D, 4096, (bf16_t*)(wsw + W_PIN + j * W_PIN_SZ), 0, scr, r, lane); continue; } r -= I_C;
        if (r < 4 * I_D) { const int g = r / I_D; transpose_item(a.in[I_PWGRP] + (size_t)(j * 4 + g) * 512 * 512, 512, 512, 512, (bf16_t*)(wsw + W_PGRP + j * W_PGRP_SZ), g * 512, scr, r % I_D, lane); continue; } r -= 4 * I_D;
        transpose_item(a.in[I_PWOUT] + (size_t)j * 2048 * D, D, 2048, D, (bf16_t*)(wsw + W_POUT + j * W_POUT_SZ), 0, scr, r, lane);
    }
    const int gt = blockIdx.x * NTHREADS + threadIdx.x, NGT = gridDim.x * NTHREADS;
    for (int idx = gt; idx < 2 * 16 * D; idx += NGT) { const int j = idx >> 14, n = (idx >> 10) & 15, k = idx & 1023;
        ((bf16_t*)(wsw + W_LR + j * W_LR_SZ))[n * D + k] = f2bf(a.in[I_GWIN][(size_t)j * D * GNIN + (size_t)k * GNIN + GNH + n]); }
    const float* x = a.in[I_X]; bf16_t* xb = (bf16_t*)(a.ws + WS_XB);
    for (size_t i = (size_t)gt * 8; i < (size_t)M * D; i += (size_t)NGT * 8) {
        const f32x4 v0 = *(const f32x4*)(x + i), v1 = *(const f32x4*)(x + i + 4);
        u32x4 w; w.x = cvt_pk_bf16(v0[0], v0[1]); w.y = cvt_pk_bf16(v0[2], v0[3]); w.z = cvt_pk_bf16(v1[0], v1[1]); w.w = cvt_pk_bf16(v1[2], v1[3]);
        *(u32x4*)(xb + i) = w; }
}

__device__ __forceinline__ void lr_phase(const bf16_t* xb, const bf16_t* wlr, float* LR, int wid, int lane) {
    const int gw = blockIdx.x * 8 + wid, NGW = gridDim.x * 8, fr = lane & 15, fq = lane >> 4;
    for (int rg = gw; rg < M / 16; rg += NGW) {
        f32x4 acc = (f32x4){0.f, 0.f, 0.f, 0.f};
        const bf16_t* ap = xb + (size_t)(rg * 16 + fr) * D + 8 * fq; const bf16_t* bp = wlr + (size_t)fr * D + 8 * fq;
#pragma unroll 8
        for (int ks = 0; ks < D / 32; ++ks) { const bf16x8 av = *(const bf16x8*)(ap + ks * 32), bv = *(const bf16x8*)(bp + ks * 32);
            acc = __builtin_amdgcn_mfma_f32_16x16x32_bf16(av, bv, acc, 0, 0, 0); }
#pragma unroll
        for (int e = 0; e < 4; ++e) LR[(size_t)(rg * 16 + 4 * fq + e) * 16 + fr] = acc[e];
    }
}

constexpr int QE_OFF = 0, KE_OFF = 17408, KDT_OFF = 34816, VT_OFF = 53248, P_OFF = 90112, SEG_OFF = 99328, DEC_OFF = 101376, SSQ_OFF = 101888, RSTD_OFF = 103936, LRS_OFF = 104192, BC_OFF = 108288;
constexpr int QS = 136, TS = 72;

template <bool FULL>
__device__ __forceinline__ float gla_build(unsigned char* sm, const bf16_t* Hb, const float* LR, const float* wgk, const float* bgk, int m0, int h, int wid, int lane) {
    const int seg = wid >> 1, c = ((wid & 1) << 6) + lane;
    float* LRS = (float*)(sm + LRS_OFF); float* BC = (float*)(sm + BC_OFF);
    if (wid < 4) *(f32x4*)(LRS + (wid * 64 + lane) * 4) = *(const f32x4*)(LR + (size_t)m0 * 16 + (wid * 64 + lane) * 4);
    float run = 0.f;
    {
        float wg[16];
#pragma unroll
        for (int r = 0; r < 16; ++r) wg[r] = wgk[r * 512 + h * DK + c];
        const float bg = bgk[h * DK + c];
        __syncthreads();
#pragma unroll 2
        for (int i = 0; i < 16; ++i) {
            const f32x4* lr = (const f32x4*)(LRS + (seg * 16 + i) * 16);
            const f32x4 l0 = lr[0], l1 = lr[1], l2 = lr[2], l3 = lr[3];
            float z = bg;
            z += l0[0] * wg[0] + l0[1] * wg[1] + l0[2] * wg[2] + l0[3] * wg[3];
            z += l1[0] * wg[4] + l1[1] * wg[5] + l1[2] * wg[6] + l1[3] * wg[7];
            z += l2[0] * wg[8] + l2[1] * wg[9] + l2[2] * wg[10] + l2[3] * wg[11];
            z += l3[0] * wg[12] + l3[1] * wg[13] + l3[2] * wg[14] + l3[3] * wg[15];
            const float ls = fminf(z, 0.f) - __logf(1.f + __expf(-fabsf(z)));
            run += ls * (1.f / 16.f); BC[(seg * 16 + i) * 128 + c] = run;
        }
    }
    float* SEG = (float*)(sm + SEG_OFF); float* DEC = (float*)(sm + DEC_OFF);
    SEG[seg * 128 + c] = run;
    __syncthreads();
    const float s0 = SEG[c], s1 = SEG[128 + c], s2 = SEG[256 + c], s3 = SEG[384 + c];
    const float off = (seg > 0 ? s0 : 0.f) + (seg > 1 ? s1 : 0.f) + (seg > 2 ? s2 : 0.f);
    const float blast = (s0 + s1) + (s2 + s3);
    if (seg == 0) DEC[c] = __expf(blast);
    const unsigned hq0 = (unsigned)(m0 + seg * 16) * GNH + h * DK + c;
    bf16_t* QE = (bf16_t*)(sm + QE_OFF); bf16_t* KE = (bf16_t*)(sm + KE_OFF); bf16_t* KDT = (bf16_t*)(sm + KDT_OFF);
#pragma unroll 2
    for (int i = 0; i < 16; i += 2) {
        const float bc0 = off + BC[(seg * 16 + i) * 128 + c], bc1 = off + BC[(seg * 16 + i + 1) * 128 + c];
        const float kf0 = bf2f(Hb[hq0 + i * GNH + 512]), kf1 = bf2f(Hb[hq0 + (i + 1) * GNH + 512]);
        if (FULL) { const float qf0 = bf2f(Hb[hq0 + i * GNH]), qf1 = bf2f(Hb[hq0 + (i + 1) * GNH]);
            QE[(seg * 16 + i) * QS + c] = f2bf(qf0 * 0.08838834764831845f * __expf(bc0));
            KE[(seg * 16 + i) * QS + c] = f2bf(kf0 * __expf(-bc0));
            QE[(seg * 16 + i + 1) * QS + c] = f2bf(qf1 * 0.08838834764831845f * __expf(bc1));
            KE[(seg * 16 + i + 1) * QS + c] = f2bf(kf1 * __expf(-bc1)); }
        *(unsigned*)(KDT + c * TS + seg * 16 + i) = cvt_pk_bf16(kf0 * __expf(blast - bc0), kf1 * __expf(blast - bc1));
    }
    return blast;
}
__device__ __forceinline__ void gla_build_vt(unsigned char* sm, const bf16_t* Hb, int m0, int h, int tid) {
    const int dv = tid & 255, half = tid >> 8;
    const unsigned hv0 = (unsigned)(m0 + half * 32) * GNH + 1024 + h * DV + dv;
    bf16_t* VT = (bf16_t*)(sm + VT_OFF);
#pragma unroll 1
    for (int blk = 0; blk < 4; ++blk) { unsigned pk[4];
#pragma unroll
        for (int e = 0; e < 4; ++e) { const unsigned lo = Hb[hv0 + (blk * 8 + 2 * e) * GNH], hi = Hb[hv0 + (blk * 8 + 2 * e + 1) * GNH]; pk[e] = lo | (hi << 16); }
        *(u32x4*)(VT + dv * TS + half * 32 + blk * 8) = (u32x4){pk[0], pk[1], pk[2], pk[3]}; }
}
__device__ __forceinline__ void gla_update(unsigned char* sm, f32x4 (&S)[8][2], int w, int fr, int fq) {
    const float* DEC = (const float*)(sm + DEC_OFF); const bf16_t* KDT = (const bf16_t*)(sm + KDT_OFF); const bf16_t* VT = (const bf16_t*)(sm + VT_OFF);
#pragma unroll
    for (int a = 0; a < 8; ++a) { const f32x4 d4 = *(const f32x4*)(DEC + 16 * a + 4 * fq); S[a][0] *= d4; S[a][1] *= d4; }
#pragma unroll
    for (int ks = 0; ks < 2; ++ks) {
        const bf16x8 y0 = *(const bf16x8*)(VT + (32 * w + fr) * TS + 32 * ks + 8 * fq), y1 = *(const bf16x8*)(VT + (32 * w + 16 + fr) * TS + 32 * ks + 8 * fq);
#pragma unroll
        for (int a = 0; a < 8; ++a) { const bf16x8 x = *(const bf16x8*)(KDT + (16 * a + fr) * TS + 32 * ks + 8 * fq);
            S[a][0] = __builtin_amdgcn_mfma_f32_16x16x32_bf16(x, y0, S[a][0], 0, 0, 0);
            S[a][1] = __builtin_amdgcn_mfma_f32_16x16x32_bf16(x, y1, S[a][1], 0, 0, 0); }
    }
}

__device__ __forceinline__ void gla_kv_phase(const Args& a, unsigned char* sm, int j) {
    int tid = threadIdx.x; asm volatile("" : "+v"(tid));
    const int wid = __builtin_amdgcn_readfirstlane(tid >> 6), lane = tid & 63, fr = lane & 15, fq = lane >> 4, w = wid;
    const bf16_t* Hb = (const bf16_t*)(a.ws + WS_H); const float* LR = (const float*)(a.ws + WS_LR);
    float* KVG = (float*)(a.ws + WS_KVG); float* DECG = (float*)(a.ws + WS_DEC);
#pragma unroll 1
    for (int item = blockIdx.x; item < 16 * NG; item += gridDim.x) {
        const int bh = item / NG, grp = item % NG, b = bh >> 2, h = bh & 3;
        if (grp == NG - 1) continue;
        const int c = ((wid & 1) << 6) + lane;
        const float* wgk = a.in[I_GWGK] + (size_t)j * GR * 512; const float* bgk = a.in[I_GBGK] + j * 512;
        f32x4 S[8][2];
#pragma unroll
        for (int x = 0; x < 8; ++x) { S[x][0] = (f32x4){0.f, 0.f, 0.f, 0.f}; S[x][1] = (f32x4){0.f, 0.f, 0.f, 0.f}; }
        float blsum = 0.f;
#pragma unroll 1
        for (int ch = 0; ch < GC; ++ch) {
            const int m0 = b * T + (grp * GC + ch) * 64;
            { int t1 = tid; asm volatile("" : "+v"(t1)); blsum += gla_build<false>(sm, Hb, LR, wgk, bgk, m0, h, wid, t1 & 63); }
            { int t1 = tid; asm volatile("" : "+v"(t1)); gla_build_vt(sm, Hb, m0, h, t1); }
            __syncthreads();
            int t2 = tid; asm volatile("" : "+v"(t2));
            gla_update(sm, S, w, t2 & 15, (t2 >> 4) & 3);
            __syncthreads();
        }
        { f32x4* dst = (f32x4*)KVG; const unsigned i0 = (unsigned)(bh * NG + grp) * 8192u + (unsigned)(w * 16 * 64 + lane);
#pragma unroll
          for (int x = 0; x < 8; ++x)
#pragma unroll
              for (int y = 0; y < 2; ++y) dst[i0 + (x * 2 + y) * 64] = S[x][y]; }
        if (wid < 2) DECG[(size_t)(bh * NG + grp) * 128 + c] = __expf(blsum);
    }
}
__device__ __forceinline__ void gla_scan_phase(const Args& a) {
    float* KVG = (float*)(a.ws + WS_KVG); const float* DECG = (const float*)(a.ws + WS_DEC);
    const int NGT = gridDim.x * NTHREADS;
    for (int gid = blockIdx.x * NTHREADS + threadIdx.x; gid < 16 * 8192; gid += NGT) {
        const int bh = gid >> 13, u = gid & 8191, ln = u & 63, tile = u >> 6, ta = (tile & 15) >> 1, fq = ln >> 4;
        f32x4 S = (f32x4){0.f, 0.f, 0.f, 0.f};
#pragma unroll 4
        for (int g = 0; g < NG; ++g) {
            float* p = KVG + ((size_t)(bh * NG + g) * 8192 + u) * 4;
            if (g < NG - 1) {
                const f32x4 kv = *(const f32x4*)p;
                const f32x4 d4 = *(const f32x4*)(DECG + (size_t)(bh * NG + g) * 128 + 16 * ta + 4 * fq);
                *(f32x4*)p = S;
                S = d4 * S + kv;
            } else *(f32x4*)p = S;
        }
    }
}
__device__ __forceinline__ void gla_out_phase(const Args& a, unsigned char* sm, int j) {
    int tid = threadIdx.x; asm volatile("" : "+v"(tid));
    const int wid = __builtin_amdgcn_readfirstlane(tid >> 6), lane = tid & 63, w = wid;
    const bf16_t* Hb = (const bf16_t*)(a.ws + WS_H); const float* LR = (const float*)(a.ws + WS_LR);
    const float* KVG = (const float*)(a.ws + WS_KVG); bf16_t* OG = (bf16_t*)(a.ws + WS_OG);
    const bf16_t* QE = (const bf16_t*)(sm + QE_OFF); const bf16_t* KE = (const bf16_t*)(sm + KE_OFF); const bf16_t* VT = (const bf16_t*)(sm + VT_OFF);
    bf16_t* P = (bf16_t*)(sm + P_OFF); float* SSQ = (float*)(sm + SSQ_OFF); float* RSTD = (float*)(sm + RSTD_OFF);
#pragma unroll 1
    for (int item = blockIdx.x; item < 16 * NG; item += gridDim.x) {
        const int bh = item / NG, grp = item % NG, b = bh >> 2, h = bh & 3;
        const int c = ((wid & 1) << 6) + lane;
        const float* wgk = a.in[I_GWGK] + (size_t)j * GR * 512; const float* bgk = a.in[I_GBGK] + j * 512;
        const float nw0 = a.in[I_GNW][j * DV + 32 * w + (lane & 15)], nw1 = a.in[I_GNW][j * DV + 32 * w + 16 + (lane & 15)];
        f32x4 S[8][2];
        { const f32x4* src = (const f32x4*)KVG; const unsigned i0 = (unsigned)(bh * NG + grp) * 8192u + (unsigned)(w * 16 * 64 + lane);
#pragma unroll
          for (int x = 0; x < 8; ++x)
#pragma unroll
              for (int y = 0; y < 2; ++y) S[x][y] = src[i0 + (x * 2 + y) * 64]; }
#pragma unroll 1
        for (int ch = 0; ch < GC; ++ch) {
            const int m0 = b * T + (grp * GC + ch) * 64;
            { int t1 = tid; asm volatile("" : "+v"(t1)); gla_build<true>(sm, Hb, LR, wgk, bgk, m0, h, wid, t1 & 63); }
            { int t1 = tid; asm volatile("" : "+v"(t1)); gla_build_vt(sm, Hb, m0, h, t1); }
            __syncthreads();
            int t2 = tid; asm volatile("" : "+v"(t2));
            const int fr = t2 & 15, fq = (t2 >> 4) & 3;
            { const int ti = w >> 1;
#pragma unroll
              for (int q = 0; q < 2; ++q) { const int tj = (w & 1) * 2 + q; f32x4 pa = (f32x4){0.f, 0.f, 0.f, 0.f};
                  if (tj <= ti) {
#pragma unroll
                      for (int ks = 0; ks < 4; ++ks) { const bf16x8 xk = *(const bf16x8*)(KE + (16 * tj + fr) * QS + 32 * ks + 8 * fq), yq = *(const bf16x8*)(QE + (16 * ti + fr) * QS + 32 * ks + 8 * fq);
                          pa = __builtin_amdgcn_mfma_f32_16x16x32_bf16(xk, yq, pa, 0, 0, 0); } }
                  const int i = 16 * ti + fr, jb = 16 * tj + 4 * fq;
#pragma unroll
                  for (int e = 0; e < 4; ++e) if (jb + e > i) pa[e] = 0.f;
                  *(u32x2*)(P + i * TS + jb) = (u32x2){cvt_pk_bf16(pa[0], pa[1]), cvt_pk_bf16(pa[2], pa[3])}; } }
            __syncthreads();
            f32x4 O[4][2];
#pragma unroll
            for (int ti = 0; ti < 4; ++ti) { O[ti][0] = (f32x4){0.f, 0.f, 0.f, 0.f}; O[ti][1] = (f32x4){0.f, 0.f, 0.f, 0.f}; }
#pragma unroll
            for (int ks = 0; ks < 2; ++ks) {
                const bf16x8 y0 = *(const bf16x8*)(VT + (32 * w + fr) * TS + 32 * ks + 8 * fq), y1 = *(const bf16x8*)(VT + (32 * w + 16 + fr) * TS + 32 * ks + 8 * fq);
#pragma unroll
                for (int ti = 0; ti < 4; ++ti) { const bf16x8 x = *(const bf16x8*)(P + (16 * ti + fr) * TS + 32 * ks + 8 * fq);
                    O[ti][0] = __builtin_amdgcn_mfma_f32_16x16x32_bf16(x, y0, O[ti][0], 0, 0, 0);
                    O[ti][1] = __builtin_amdgcn_mfma_f32_16x16x32_bf16(x, y1, O[ti][1], 0, 0, 0); }
            }
#pragma unroll
            for (int kk = 0; kk < 4; ++kk) {
                bf16x8 ys[2];
#pragma unroll
                for (int y = 0; y < 2; ++y) { const f32x4 sa = S[2 * kk][y], sb = S[2 * kk + 1][y];
                    const u32x4 pk = (u32x4){cvt_pk_bf16(sa[0], sa[1]), cvt_pk_bf16(sa[2], sa[3]), cvt_pk_bf16(sb[0], sb[1]), cvt_pk_bf16(sb[2], sb[3])};
                    ys[y] = __builtin_bit_cast(bf16x8, pk); }
#pragma unroll
                for (int ti = 0; ti < 4; ++ti) {
                    const u32x2 lo = *(const u32x2*)(QE + (16 * ti + fr) * QS + 32 * kk + 4 * fq), hi = *(const u32x2*)(QE + (16 * ti + fr) * QS + 32 * kk + 16 + 4 * fq);
                    const bf16x8 x = __builtin_bit_cast(bf16x8, ((u32x4){lo.x, lo.y, hi.x, hi.y}));
                    O[ti][0] = __builtin_amdgcn_mfma_f32_16x16x32_bf16(x, ys[0], O[ti][0], 0, 0, 0);
                    O[ti][1] = __builtin_amdgcn_mfma_f32_16x16x32_bf16(x, ys[1], O[ti][1], 0, 0, 0); }
            }
            gla_update(sm, S, w, fr, fq);
#pragma unroll
            for (int ti = 0; ti < 4; ++ti)
#pragma unroll
                for (int e = 0; e < 4; ++e) { float p = O[ti][0][e] * O[ti][0][e] + O[ti][1][e] * O[ti][1][e];
                    p += __shfl_xor(p, 1); p += __shfl_xor(p, 2); p += __shfl_xor(p, 4); p += __shfl_xor(p, 8);
                    if (fr == 0) SSQ[w * 64 + 16 * ti + 4 * fq + e] = p; }
            __syncthreads();
            if (tid < 64) { float s = 0.f;
#pragma unroll
                for (int ww = 0; ww < 8; ++ww) s += SSQ[ww * 64 + tid];
                RSTD[tid] = rsqrtf(s * (1.f / DV) + RMS_EPS); }
            __syncthreads();
            int t3 = tid; asm volatile("" : "+v"(t3));
            const int fr3 = t3 & 15, fq3 = (t3 >> 4) & 3;
#pragma unroll
            for (int ti = 0; ti < 4; ++ti) {
                asm volatile("" ::: "memory");
#pragma unroll
                for (int e = 0; e < 4; ++e) { const int i = 16 * ti + 4 * fq3 + e; const float r = RSTD[i];
                    const unsigned gi = (unsigned)(m0 + i) * GNH + 2048 + h * DV + 32 * w + fr3;
                    const unsigned oi = (unsigned)(m0 + i) * D + h * DV + 32 * w + fr3;
                    OG[oi] = f2bf(O[ti][0][e] * r * nw0 * silu_f(bf2f(Hb[gi])));
                    OG[oi + 16] = f2bf(O[ti][1][e] * r * nw1 * silu_f(bf2f(Hb[gi + 16]))); } }
        }
    }
}

__device__ __forceinline__ void ln_phase(float* X, bf16_t* XB, const float* g, const float* bta) {
    int tid = threadIdx.x; asm volatile("" : "+v"(tid));
    const int wid = __builtin_amdgcn_readfirstlane(tid >> 6), lane = tid & 63;
    const int gw = blockIdx.x * 8 + wid, NGW = gridDim.x * 8;
    f32x4 gv[4], bv[4];
#pragma unroll
    for (int jj = 0; jj < 4; ++jj) { gv[jj] = *(const f32x4*)(g + 4 * lane + 256 * jj); bv[jj] = *(const f32x4*)(bta + 4 * lane + 256 * jj); }
    for (int m = gw; m < M; m += NGW) {
        f32x4* xr = (f32x4*)(X + (size_t)m * D) + lane;
        f32x4 v[4]; float s = 0.f;
#pragma unroll
        for (int jj = 0; jj < 4; ++jj) { v[jj] = xr[64 * jj]; s += (v[jj][0] + v[jj][1]) + (v[jj][2] + v[jj][3]); }
        const float mean = wave_sum(s) * (1.f / D); float s2 = 0.f;
#pragma unroll
        for (int jj = 0; jj < 4; ++jj) { v[jj] = v[jj] - mean; s2 += (v[jj][0] * v[jj][0] + v[jj][1] * v[jj][1]) + (v[jj][2] * v[jj][2] + v[jj][3] * v[jj][3]); }
        const float rstd = rsqrtf(wave_sum(s2) * (1.f / D) + LN_EPS);
        u32x2* ob = (u32x2*)(XB + (size_t)m * D) + lane;
#pragma unroll
        for (int jj = 0; jj < 4; ++jj) { const f32x4 y = v[jj] * rstd * gv[jj] + bv[jj]; xr[64 * jj] = y;
            ob[64 * jj] = (u32x2){cvt_pk_bf16(y[0], y[1]), cvt_pk_bf16(y[2], y[3])}; }
    }
}

__device__ __forceinline__ void pool_phase(const bf16_t* U, bf16_t* Pp) {
    int tid = threadIdx.x; asm volatile("" : "+v"(tid));
    const int vc = tid & 255, half = tid >> 8, win = 2 << (vc >> 6);
    for (int seg = blockIdx.x; seg < M / 64; seg += gridDim.x) {
        const int mbase = seg * 64 + half * 32;
        const int t0 = mbase & (T - 1);
        const bf16_t* up = U + (size_t)mbase * PW + vc * 8;
        bf16_t* pp = Pp + (size_t)mbase * PW + vc * 8;
        float sum[8];
#pragma unroll
        for (int e = 0; e < 8; ++e) sum[e] = 0.f;
        for (int d = 1; d < win; ++d) if (t0 - d >= 0) { const u32x4 q = *(const u32x4*)(up - (size_t)d * PW);
            sum[0] += bflo(q.x); sum[1] += bfhi(q.x); sum[2] += bflo(q.y); sum[3] += bfhi(q.y); sum[4] += bflo(q.z); sum[5] += bfhi(q.z); sum[6] += bflo(q.w); sum[7] += bfhi(q.w); }
        for (int i = 0; i < 32; ++i) {
            const int t = t0 + i;
            const u32x4 q = *(const u32x4*)(up + (size_t)i * PW);
            float u8[8] = {bflo(q.x), bfhi(q.x), bflo(q.y), bfhi(q.y), bflo(q.z), bfhi(q.z), bflo(q.w), bfhi(q.w)};
            const float inv = 1.f / (float)min(t + 1, win);
            float o[8];
#pragma unroll
            for (int e = 0; e < 8; ++e) { sum[e] += u8[e]; o[e] = sum[e] * inv - u8[e]; }
            *(u32x4*)(pp + (size_t)i * PW) = (u32x4){cvt_pk_bf16(o[0], o[1]), cvt_pk_bf16(o[2], o[3]), cvt_pk_bf16(o[4], o[5]), cvt_pk_bf16(o[6], o[7])};
            if (t - win + 1 >= 0) { const u32x4 r = *(const u32x4*)(up + (size_t)(i - win + 1) * PW);
                sum[0] -= bflo(r.x); sum[1] -= bfhi(r.x); sum[2] -= bflo(r.y); sum[3] -= bfhi(r.y); sum[4] -= bflo(r.z); sum[5] -= bfhi(r.z); sum[6] -= bflo(r.w); sum[7] -= bfhi(r.w); }
        }
    }
}

#define XB_TMO      128
#define XB_XCNT(j)  (256  + 64 * (j))
#define XB_XSUB(j)  (1280 + 64 * (j))
#define XB_XGEN(j)  (2304 + 64 * (j))
#define XB_TOP      3328
#define XB_TOPGEN   3392
#define XCD_BAR_WORDS 3456
#define XB_SPIN_CAP (1u << 18)
__device__ __forceinline__ unsigned xb_ld(unsigned* p)              { return __hip_atomic_load(p, __ATOMIC_RELAXED, __HIP_MEMORY_SCOPE_AGENT); }
__device__ __forceinline__ unsigned xb_add(unsigned* p, unsigned v) { return __hip_atomic_fetch_add(p, v, __ATOMIC_RELAXED, __HIP_MEMORY_SCOPE_AGENT); }
__device__ __forceinline__ unsigned xb_xcc_id() { return (unsigned)__builtin_amdgcn_s_getreg((3 << 11) | 20) & 0xFu; }
#define XB_SPIN(cond, bar) do { unsigned _sp = 0; while (cond) { __builtin_amdgcn_s_sleep(1); \
    if ((++_sp & 255u) == 0u) { if (xb_ld(&(bar)[XB_TMO])) break; if (_sp > XB_SPIN_CAP) { atomicAdd(&(bar)[XB_TMO], 1u); break; } } } } while (0)
struct XcdBarrier { unsigned* bar; unsigned x; volatile LAS unsigned* st; };
__device__ __forceinline__ XcdBarrier xcd_barrier_post(unsigned* bar, volatile LAS unsigned* st) {
    XcdBarrier b; b.bar = bar; b.x = xb_xcc_id(); b.st = st;
    if (threadIdx.x == 0) (void)xb_add(&bar[XB_XCNT(b.x)], 1u);
    return b;
}
__device__ __forceinline__ void xcd_barrier_complete(unsigned* bar, unsigned x, unsigned& nloc, unsigned& nx) {
    const unsigned G = gridDim.x * gridDim.y * gridDim.z;
    unsigned sum, cnt, mine, sp = 0u;
    for (;;) {
        sum = 0u; cnt = 0u; mine = 0u;
#pragma unroll
        for (unsigned j = 0; j < 16; ++j) { const unsigned c = xb_ld(&bar[XB_XCNT(j)]); sum += c; cnt += (c > 0u) ? 1u : 0u; mine = (j == x) ? c : mine; }
        if (sum == G) break;
        __builtin_amdgcn_s_sleep(1);
        if ((++sp & 255u) == 0u) { if (xb_ld(&bar[XB_TMO])) break; if (sp > XB_SPIN_CAP) { atomicAdd(&bar[XB_TMO], 1u); break; } }
    }
    nloc = mine > 0u ? mine : 1u; nx = cnt > 0u ? cnt : 1u;
}
__device__ __forceinline__ void xcd_barrier(const XcdBarrier& b) {
    asm volatile("s_waitcnt vmcnt(0)" ::: "memory");
    __syncthreads();
    if (threadIdx.x == 0) {
        unsigned* bar = b.bar;
        __builtin_amdgcn_s_waitcnt(0);
        unsigned nloc = b.st[0], nx = b.st[1];
        if (nloc == 0u) { xcd_barrier_complete(bar, b.x, nloc, nx); b.st[0] = nloc; b.st[1] = nx; }
        const unsigned old = xb_add(&bar[XB_XSUB(b.x)], 1u);
        const unsigned gen = old / nloc;
        if (old + 1u == (gen + 1u) * nloc) {
            __builtin_amdgcn_fence(__ATOMIC_RELEASE, "agent");
            asm volatile("s_waitcnt vmcnt(0)" ::: "memory");
            const unsigned og = xb_add(&bar[XB_TOP], 1u);
            const unsigned tg = og / nx;
            if (og + 1u == (tg + 1u) * nx) xb_add(&bar[XB_TOPGEN], 1u);
            else XB_SPIN(xb_ld(&bar[XB_TOPGEN]) == tg, bar);
            __builtin_amdgcn_fence(__ATOMIC_ACQUIRE, "agent");
            xb_add(&bar[XB_XGEN(b.x)], 1u);
            asm volatile("s_waitcnt vmcnt(0)" ::: "memory");
        } else {
            XB_SPIN(xb_ld(&bar[XB_XGEN(b.x)]) == gen, bar);
            __builtin_amdgcn_fence(__ATOMIC_ACQUIRE, "agent");
            asm volatile("s_waitcnt vmcnt(0)" ::: "memory");
        }
    }
    __syncthreads();
}
constexpr int MISC_OFF = 147200;

typedef const __attribute__((address_space(4))) Args* ArgP;
__device__ __forceinline__ ArgP argp() { ArgP p = (ArgP)__builtin_amdgcn_kernarg_segment_ptr(); asm volatile("" : "+s"(p)); return p; }
__device__ __forceinline__ Args argv() { ArgP p = argp(); Args a;
#pragma unroll
    for (int i = 0; i < 13; ++i) a.in[i] = p->in[i];
    a.out = p->out; a.ws = p->ws; return a; }

__global__ void __launch_bounds__(NTHREADS, 2) mega_fwd(Args a_unused) {
    extern __shared__ __attribute__((aligned(16))) unsigned char smem[];
    cg::grid_group grid = cg::this_grid();
    LAS unsigned char* lds = (LAS unsigned char*)smem;
    volatile LAS unsigned* bst = (volatile LAS unsigned*)(lds + MISC_OFF);
    if (threadIdx.x < 2) bst[threadIdx.x] = 0u;
    __syncthreads();
    const XcdBarrier gbar = xcd_barrier_post((unsigned*)argp()->ws, bst);

    { const Args a = argv(); int tid = threadIdx.x; asm volatile("" : "+v"(tid));
      prologue_phase(a, smem, __builtin_amdgcn_readfirstlane(tid >> 6), tid & 63); }
    grid.sync();

#pragma unroll 1
    for (int L = 0; L < 4; ++L) {
        const int j = L >> 1;
        if ((L & 1) == 0) {
            { ArgP p = argp(); unsigned char* ws = p->ws; unsigned char* wsw = ws + WS_W;
              pg8::Gemm g{(const bf16_t*)(ws + WS_XB), (const bf16_t*)(wsw + W_GIN + j * W_GIN_SZ), M, GNH, D, D, 1 << 30, 0}; pg8::StaticOrder S; S.init(M, GNH, gridDim.x, (int)blockIdx.x);
              pg8::EpiBf16 E{(bf16_t*)(ws + WS_H), GNH, 0, 0};
              pg8::gemm_phase(lds, g, S, E); }
            { ArgP p = argp(); unsigned char* ws = p->ws; unsigned char* wsw = ws + WS_W; int tid = threadIdx.x; asm volatile("" : "+v"(tid));
              lr_phase((const bf16_t*)(ws + WS_XB), (const bf16_t*)(wsw + W_LR + j * W_LR_SZ), (float*)(ws + WS_LR), __builtin_amdgcn_readfirstlane(tid >> 6), tid & 63); }
            xcd_barrier(gbar);
            { const Args a = argv(); gla_kv_phase(a, smem, j); }
            xcd_barrier(gbar);
            { const Args a = argv(); gla_scan_phase(a); }
            xcd_barrier(gbar);
            { const Args a = argv(); gla_out_phase(a, smem, j); }
            xcd_barrier(gbar);
            { ArgP p = argp(); unsigned char* ws = p->ws; unsigned char* wsw = ws + WS_W; float* out = p->out; const float* base = (L == 0) ? p->in[I_X] : out;
              pg8::Gemm g{(const bf16_t*)(ws + WS_OG), (const bf16_t*)(wsw + W_GOUT + j * W_GOUT_SZ), M, D, D, D, 1 << 30, 0}; pg8::StaticOrder S; S.init(M, D, gridDim.x, (int)blockIdx.x);
              pg8::EpiRes E{base, out, D};
              pg8::gemm_phase(lds, g, S, E); }
        } else {
            { ArgP p = argp(); unsigned char* ws = p->ws; unsigned char* wsw = ws + WS_W;
              pg8::Gemm g{(const bf16_t*)(ws + WS_XB), (const bf16_t*)(wsw + W_PIN + j * W_PIN_SZ), M, 4096, D, D, 1 << 30, 0}; pg8::StaticOrder S; S.init(M, 4096, gridDim.x, (int)blockIdx.x);
              pg8::EpiBf16 E{(bf16_t*)(ws + WS_H), PW, PW, (size_t)(WS_Z - WS_H) / 2};
              pg8::gemm_phase(lds, g, S, E); }
            xcd_barrier(gbar);
            { ArgP p = argp(); unsigned char* ws = p->ws; pool_phase((const bf16_t*)(ws + WS_H), (bf16_t*)(ws + WS_P)); }
            xcd_barrier(gbar);
            { ArgP p = argp(); unsigned char* ws = p->ws; unsigned char* wsw = ws + WS_W;
              pg8::Gemm g{(const bf16_t*)(ws + WS_P), (const bf16_t*)(wsw + W_PGRP + j * W_PGRP_SZ), M, PW, 512, PW, 2, 512}; pg8::StaticOrder S; S.init(M, PW, gridDim.x, (int)blockIdx.x);
              pg8::EpiPool E{(bf16_t*)(ws + WS_Y), (const bf16_t*)(ws + WS_Z), p->in[I_PBGRP] + j * PW, p->in[I_PSCALE] + j * PW};
              pg8::gemm_phase(lds, g, S, E); }
            xcd_barrier(gbar);
            { ArgP p = argp(); unsigned char* ws = p->ws; unsigned char* wsw = ws + WS_W; float* out = p->out; const float* base = out;
              pg8::Gemm g{(const bf16_t*)(ws + WS_Y), (const bf16_t*)(wsw + W_POUT + j * W_POUT_SZ), M, D, PW, PW, 1 << 30, 0}; pg8::StaticOrder S; S.init(M, D, gridDim.x, (int)blockIdx.x);
              pg8::EpiRes E{base, out, D};
              pg8::gemm_phase(lds, g, S, E); }
        }
        xcd_barrier(gbar);
        { ArgP p = argp(); ln_phase(p->out, (bf16_t*)(p->ws + WS_XB), p->in[I_LNG] + L * D, p->in[I_LNB] + L * D); }
        if (L < 3) xcd_barrier(gbar);
    }
}

extern "C" void kernel_launch(void* const* d_in, const int* in_sizes, int n_in, void* d_out, int out_size, void* d_ws, size_t ws_size, hipStream_t stream) {
    static int grid_blocks = 0;
    if (!grid_blocks) {
        int dev = 0, cus = 0, per_cu = 0;
        (void)hipGetDevice(&dev);
        (void)hipDeviceGetAttribute(&cus, hipDeviceAttributeMultiprocessorCount, dev);
        (void)hipFuncSetAttribute((const void*)mega_fwd, hipFuncAttributeMaxDynamicSharedMemorySize, LDS_BYTES);
        (void)hipOccupancyMaxActiveBlocksPerMultiprocessor(&per_cu, (const void*)mega_fwd, NTHREADS, LDS_BYTES);
        if (per_cu < 1) per_cu = 1;
        grid_blocks = cus * per_cu;
    }
    Args a{};
    for (int i = 0; i < 13; ++i) a.in[i] = (const float*)d_in[i];
    a.out = (float*)d_out; a.ws = (unsigned char*)d_ws;
    (void)hipMemsetAsync(d_ws, 0, 65536, stream);
    void* args[] = {&a};
    hipError_t e = hipLaunchCooperativeKernel((void*)mega_fwd, dim3(grid_blocks), dim3(NTHREADS), args, LDS_BYTES, stream);
    if (e != hipSuccess) fprintf(stderr, "cooperative launch failed: %s (grid %d)\n", hipGetErrorString(e), grid_blocks);
}
```
